# Optimizing an MI355X kernel written in HIP

```python
import jax
import jax.numpy as jnp
from jax import lax
import numpy as np

D_MODEL = 2048
BATCH = 4
SEQ = 4096
DEPTH = 2

GRID_W = 64
CTX_LEN = 256
D_GROUP = D_MODEL // 2
CONF_KERNEL = 31
LRU_CONV = 4
LRU_BLOCKS = 16
LRU_BLOCK_DIM = D_GROUP // LRU_BLOCKS
LRU_C = 8.0
NA_HEADS = 8
NA_KH = 8
NA_KW = 16
HG_HEADS = 8
HG_HEAD_DIM = D_GROUP // HG_HEADS
HG_CHUNK = 64
N_EXPERTS = 16
D_FF_EXPERT = 2048
EC_FACTOR = 2
N_AB = (DEPTH + 1) // 2
N_CD = DEPTH // 2
EPS = 1e-6
NEG_INF = -1e30

kernel_name = "hybrid_conv_rglru_natten_hgrn2_ecmoe"


def rmsnorm(x, g):
    xf = x.astype(jnp.float32)
    y = xf * lax.rsqrt(jnp.mean(xf * xf, axis=-1, keepdims=True) + EPS)
    return (y * g.astype(jnp.float32)).astype(x.dtype)


def layernorm(x, g, b):
    xf = x.astype(jnp.float32)
    mu = jnp.mean(xf, axis=-1, keepdims=True)
    var = jnp.mean(jnp.square(xf - mu), axis=-1, keepdims=True)
    y = (xf - mu) * lax.rsqrt(var + EPS)
    return (y * g.astype(jnp.float32) + b.astype(jnp.float32)).astype(x.dtype)


def modulate(h, shift, scale):
    return h * (1.0 + scale) + shift


def split_heads(t, n_heads):
    b, n, _ = t.shape
    return t.reshape(b, n, n_heads, -1).transpose(0, 2, 1, 3)


def merge_heads(t):
    b, h, n, d = t.shape
    return t.transpose(0, 2, 1, 3).reshape(b, n, h * d)


def depthwise_conv(x, w, b, pad_left, pad_right):
    y = lax.conv_general_dilated(
        x, w[:, None, :].astype(x.dtype), (1,), [(pad_left, pad_right)],
        dimension_numbers=("NWC", "WIO", "NWC"), feature_group_count=x.shape[-1])
    return y + b


def rglru_coeffs(x, w_a, b_a, w_i, b_i, lam):
    bn, n, _ = x.shape
    xb = x.reshape(bn, n, LRU_BLOCKS, LRU_BLOCK_DIM)
    r = jax.nn.sigmoid(jnp.einsum("bnhi,hij->bnhj", xb, w_a).reshape(bn, n, D_GROUP) + b_a)
    i = jax.nn.sigmoid(jnp.einsum("bnhi,hij->bnhj", xb, w_i).reshape(bn, n, D_GROUP) + b_i)
    log_a = (-LRU_C * r.astype(jnp.float32)) * jax.nn.softplus(-lam.astype(jnp.float32))
    a = jnp.exp(log_a)
    b = jnp.sqrt(-jnp.expm1(2.0 * log_a)) * (i * x).astype(jnp.float32)
    return a, b


def linear_scan(a, b, h0):
    def combine(e1, e2):
        a1, b1 = e1
        a2, b2 = e2
        return a1 * a2, a2 * b1 + b2
    a_cum, b_cum = lax.associative_scan(combine, (a, b), axis=1)
    return a_cum * h0[:, None, :] + b_cum


def rglru_direction(xl, xc, w_a, b_a, w_i, b_i, lam, reverse):
    if reverse:
        xl, xc = xl[:, ::-1], xc[:, ::-1]
    ac, bc = rglru_coeffs(xc, w_a, b_a, w_i, b_i, lam)
    hc = linear_scan(ac, bc, jnp.zeros_like(bc[:, 0]))
    al, bl = rglru_coeffs(xl, w_a, b_a, w_i, b_i, lam)
    hl = linear_scan(al, bl, hc[:, -1])
    if reverse:
        hl, hc = hl[:, ::-1], hc[:, ::-1]
    return hl.astype(xl.dtype), hc.astype(xc.dtype)


def ab_mixer(h, hc, w_in, w_out, dw_w, dw_b, ln_g, ln_b, cv_w, cv_b, wa, ba, wi, bi, lam, need_ctx):
    za, zg, zy, zx = jnp.split(h @ w_in, 4, axis=-1)
    ca, cg, cy, cx = jnp.split(hc @ w_in, 4, axis=-1)

    def conformer(a_val, a_gate):
        u = a_val * jax.nn.sigmoid(a_gate)
        u = depthwise_conv(u, dw_w, dw_b, CONF_KERNEL // 2, CONF_KERNEL // 2)
        return jax.nn.silu(layernorm(u, ln_g, ln_b))

    xl = depthwise_conv(zx, cv_w, cv_b, 2, 1)
    xcc = depthwise_conv(cx, cv_w, cv_b, 2, 1)
    f_l, f_c = rglru_direction(xl, xcc, wa[0], ba[0], wi[0], bi[0], lam[0], False)
    b_l, b_c = rglru_direction(xl, xcc, wa[1], ba[1], wi[1], bi[1], lam[1], True)
    out_l = jnp.concatenate([conformer(za, zg), jax.nn.gelu(zy) * (f_l + b_l)], axis=-1) @ w_out
    if not need_ctx:
        return out_l, None
    out_c = jnp.concatenate([conformer(ca, cg), jax.nn.gelu(cy) * (f_c + b_c)], axis=-1) @ w_out
    return out_l, out_c


def dense_attention(q, k, v):
    s = jnp.einsum("bhqd,bhkd->bhqk", q, k).astype(jnp.float32) * (q.shape[-1] ** -0.5)
    return jnp.einsum("bhqk,bhkd->bhqd", jax.nn.softmax(s, axis=-1).astype(v.dtype), v)


def na_latent(q, k, v, kc, vc, table):
    bn, nh, n, dh = q.shape
    rows = n // GRID_W
    kh = min(NA_KH, rows)
    scale = dh ** -0.5
    kg = k.reshape(bn, nh, rows, GRID_W, dh)
    vg = v.reshape(bn, nh, rows, GRID_W, dh)
    q_rows = q.reshape(bn, nh, rows, GRID_W, dh).transpose(2, 0, 1, 3, 4)
    col = jnp.arange(GRID_W)
    c0 = jnp.clip(col - NA_KW // 2, 0, GRID_W - NA_KW)
    col_mask = (col[None, :] >= c0[:, None]) & (col[None, :] < c0[:, None] + NA_KW)
    dc_idx = jnp.clip(col[None, :] - col[:, None] + NA_KW - 1, 0, 2 * NA_KW - 2)
    table_c = jnp.take(table, dc_idx, axis=2)
    band = kh * GRID_W

    def row_block(args):
        r, q_row = args
        r0 = jnp.clip(r - kh // 2, 0, rows - kh)
        k_band = lax.dynamic_slice_in_dim(kg, r0, kh, axis=2)
        v_band = lax.dynamic_slice_in_dim(vg, r0, kh, axis=2)
        dr_idx = r0 + jnp.arange(kh) - r + NA_KH - 1
        bias = jnp.take(table_c, dr_idx, axis=1).transpose(0, 2, 1, 3)
        s_lat = jnp.einsum("bhqd,bhrkd->bhqrk", q_row, k_band).astype(jnp.float32) * scale
        s_lat = s_lat + bias[None].astype(jnp.float32)
        s_lat = jnp.where(col_mask[:, None, :], s_lat, NEG_INF).reshape(bn, nh, GRID_W, band)
        s_ctx = jnp.einsum("bhqd,bhkd->bhqk", q_row, kc).astype(jnp.float32) * scale
        p = jax.nn.softmax(jnp.concatenate([s_lat, s_ctx], axis=-1), axis=-1).astype(q.dtype)
        o = jnp.einsum("bhqk,bhkd->bhqd", p[..., :band], v_band.reshape(bn, nh, band, dh))
        return o + jnp.einsum("bhqk,bhkd->bhqd", p[..., band:], vc)

    o = lax.map(row_block, (jnp.arange(rows), q_rows))
    return o.transpose(1, 2, 0, 3, 4).reshape(bn, nh, n, dh)


def hgrn_lower_bound(lb_logits, layer):
    p = jax.nn.softmax(lb_logits.astype(jnp.float32), axis=0)
    return jnp.cumsum(p, axis=0)[layer] - p[0]


def hgrn2_chunked(q, k, v, g, s0):
    bn, nh, n, dk = q.shape
    L = min(HG_CHUNK, n)
    nc = n // L
    chunks = lambda t: t.reshape(bn, nh, nc, L, t.shape[-1]).transpose(2, 0, 1, 3, 4)
    causal = jnp.tril(jnp.ones((L, L), dtype=bool))

    def step(s, inp):
        qc, kc, vc, gc = inp
        G = jnp.cumsum(gc, axis=2)
        o_inter = jnp.einsum("bhtd,bhdv->bhtv", qc * jnp.exp(G), s)
        diff = G[:, :, :, None, :] - G[:, :, None, :, :]
        decay = jnp.where(causal[:, :, None], jnp.exp(jnp.minimum(diff, 0.0)), 0.0)
        att = jnp.einsum("bhtd,bhsd,bhtsd->bhts", qc, kc, decay)
        o_intra = jnp.einsum("bhts,bhsv->bhtv", att, vc)
        g_end = G[:, :, -1:, :]
        s_new = jnp.exp(g_end[:, :, 0, :])[..., None] * s + jnp.einsum(
            "bhsd,bhsv->bhdv", kc * jnp.exp(g_end - G), vc)
        return s_new, o_inter + o_intra

    s_fin, o = lax.scan(step, s0, (chunks(q), chunks(k), chunks(v), chunks(g)))
    return s_fin, o.transpose(1, 2, 0, 3, 4).reshape(bn, nh, n, v.shape[-1])


def hgrn2_direction(zl, zc, f_idx, lb, reverse):
    def prep(z):
        q_raw, f_raw, i_raw = z[3], z[f_idx], z[6]
        if reverse:
            q_raw, f_raw, i_raw = q_raw[:, ::-1], f_raw[:, ::-1], i_raw[:, ::-1]
        f = lb + (1.0 - lb) * jax.nn.sigmoid(f_raw.astype(jnp.float32))
        return (split_heads(jax.nn.silu(q_raw.astype(jnp.float32)), HG_HEADS),
                split_heads(1.0 - f, HG_HEADS),
                split_heads(i_raw.astype(jnp.float32), HG_HEADS),
                split_heads(jnp.log(f), HG_HEADS))
    qc, kc, vc, gc = prep(zc)
    s0 = jnp.zeros((zc[3].shape[0], HG_HEADS, HG_HEAD_DIM, HG_HEAD_DIM), jnp.float32)
    s_ctx, o_c = hgrn2_chunked(qc, kc, vc, gc, s0)
    ql, kl, vl, gl = prep(zl)
    _, o_l = hgrn2_chunked(ql, kl, vl, gl, s_ctx)
    if reverse:
        o_l, o_c = o_l[:, :, ::-1], o_c[:, :, ::-1]
    return o_l, o_c


def cd_mixer(h, hc, w_in, w_out, table, lb_f, lb_b, gn_g, need_ctx):
    zl = jnp.split(h @ w_in, 8, axis=-1)
    zc = jnp.split(hc @ w_in, 8, axis=-1)
    qn, kn, vn = (split_heads(t, NA_HEADS) for t in zl[:3])
    qnc, knc, vnc = (split_heads(t, NA_HEADS) for t in zc[:3])
    o_na = merge_heads(na_latent(qn, kn, vn, knc, vnc, table))
    of_l, of_c = hgrn2_direction(zl, zc, 4, lb_f, False)
    ob_l, ob_c = hgrn2_direction(zl, zc, 5, lb_b, True)

    def hgrn_out(o, gate):
        return merge_heads(rmsnorm(o, gn_g)).astype(gate.dtype) * jax.nn.silu(gate)

    out_l = jnp.concatenate([o_na, hgrn_out(of_l + ob_l, zl[7])], axis=-1) @ w_out
    if not need_ctx:
        return out_l, None
    o_na_c = merge_heads(dense_attention(qnc, knc, vnc))
    out_c = jnp.concatenate([o_na_c, hgrn_out(of_c + ob_c, zc[7])], axis=-1) @ w_out
    return out_l, out_c


def ec_moe(h, router, w1, w3, w2):
    bn, n, _ = h.shape
    cap = EC_FACTOR * n // N_EXPERTS
    aff = jax.nn.softmax((h @ router).astype(jnp.float32), axis=-1)
    gate, idx = lax.top_k(jnp.swapaxes(aff, 1, 2), cap)
    bidx = jnp.arange(bn)[:, None, None]
    xs = h[bidx, idx]
    hid = jax.nn.silu(jnp.einsum("becd,edf->becf", xs, w1)) * jnp.einsum("becd,edf->becf", xs, w3)
    y = jnp.einsum("becf,efd->becd", hid, w2) * gate[..., None].astype(h.dtype)
    return jnp.zeros_like(h).at[bidx, idx].add(y)


def setup_inputs(seed: int = 0) -> dict:
    key = jax.random.key(seed)
    keys = jax.random.split(key, 32)
    f32 = jnp.float32
    D, G = D_MODEL, D_GROUP

    def normal(i, shape, scale):
        return jax.random.normal(keys[i], shape, f32) * scale

    lam_a = jax.random.uniform(keys[20], (N_AB, 2, G), f32, 0.9, 0.999)
    return {
        "x": normal(0, (BATCH, SEQ, D), 1.0),
        "c": normal(1, (BATCH, D), 1.0),
        "ctx": normal(2, (BATCH, CTX_LEN, D), 1.0),
        "c_ctx": normal(3, (D,), 1.0),
        "ada_w": normal(4, (DEPTH, D, 6 * D), 0.5 * D ** -0.5),
        "ada_b": normal(5, (DEPTH, 6 * D), 0.01),
        "norm_g": 1.0 + normal(6, (DEPTH, 2, D), 0.02),
        "final_g": 1.0 + normal(7, (D,), 0.02),
        "ab_w_in": normal(8, (N_AB, D, 4 * G), D ** -0.5),
        "ab_w_out": normal(9, (N_AB, 2 * G, D), (2 * G) ** -0.5),
        "conf_dw_w": normal(10, (N_AB, CONF_KERNEL, G), CONF_KERNEL ** -0.5),
        "conf_dw_b": normal(11, (N_AB, G), 0.01),
        "conf_ln_g": 1.0 + normal(12, (N_AB, G), 0.02),
        "conf_ln_b": normal(13, (N_AB, G), 0.01),
        "lru_conv_w": normal(14, (N_AB, LRU_CONV, G), LRU_CONV ** -0.5),
        "lru_conv_b": normal(15, (N_AB, G), 0.01),
        "lru_wa": normal(16, (N_AB, 2, LRU_BLOCKS, LRU_BLOCK_DIM, LRU_BLOCK_DIM), LRU_BLOCK_DIM ** -0.5),
        "lru_ba": normal(17, (N_AB, 2, G), 0.01),
        "lru_wi": normal(18, (N_AB, 2, LRU_BLOCKS, LRU_BLOCK_DIM, LRU_BLOCK_DIM), LRU_BLOCK_DIM ** -0.5),
        "lru_bi": normal(19, (N_AB, 2, G), 0.01),
        "lru_lam": jnp.log(lam_a) - jnp.log1p(-lam_a),
        "cd_w_in": normal(21, (N_CD, D, 8 * G), D ** -0.5),
        "cd_w_out": normal(22, (N_CD, 2 * G, D), (2 * G) ** -0.5),
        "na_bias": normal(23, (N_CD, NA_HEADS, 2 * NA_KH - 1, 2 * NA_KW - 1), 0.1),
        "hgrn_lb": normal(24, (2, DEPTH, G), 0.5),
        "hgrn_norm_g": 1.0 + normal(25, (N_CD, HG_HEAD_DIM), 0.02),
        "moe_router": normal(26, (DEPTH, D, N_EXPERTS), D ** -0.5),
        "moe_w1": normal(27, (DEPTH, N_EXPERTS, D, D_FF_EXPERT), D ** -0.5),
        "moe_w3": normal(28, (DEPTH, N_EXPERTS, D, D_FF_EXPERT), D ** -0.5),
        "moe_w2": normal(29, (DEPTH, N_EXPERTS, D_FF_EXPERT, D), D_FF_EXPERT ** -0.5),
    }


def reference(x, c, ctx, c_ctx, ada_w, ada_b, norm_g, final_g, ab_w_in, ab_w_out,
              conf_dw_w, conf_dw_b, conf_ln_g, conf_ln_b, lru_conv_w, lru_conv_b,
              lru_wa, lru_ba, lru_wi, lru_bi, lru_lam, cd_w_in, cd_w_out, na_bias,
              hgrn_lb, hgrn_norm_g, moe_router, moe_w1, moe_w3, moe_w2):
    xc = ctx
    s_lat = jax.nn.silu(c)
    s_ctx = jax.nn.silu(c_ctx)
    for l in range(DEPTH):
        last = l == DEPTH - 1
        j = l // 2
        mod_l = jnp.split((s_lat @ ada_w[l] + ada_b[l])[:, None, :], 6, axis=-1)
        mod_c = jnp.split(s_ctx @ ada_w[l] + ada_b[l], 6, axis=-1)
        h = modulate(rmsnorm(x, norm_g[l, 0]), mod_l[0], mod_l[1])
        hc = modulate(rmsnorm(xc, norm_g[l, 0]), mod_c[0], mod_c[1])
        if l % 2 == 0:
            o, oc = ab_mixer(h, hc, ab_w_in[j], ab_w_out[j], conf_dw_w[j], conf_dw_b[j],
                             conf_ln_g[j], conf_ln_b[j], lru_conv_w[j], lru_conv_b[j],
                             lru_wa[j], lru_ba[j], lru_wi[j], lru_bi[j], lru_lam[j], not last)
        else:
            lb_f = hgrn_lower_bound(hgrn_lb[0], l)
            lb_b = hgrn_lower_bound(hgrn_lb[1], l)
            o, oc = cd_mixer(h, hc, cd_w_in[j], cd_w_out[j], na_bias[j], lb_f, lb_b,
                             hgrn_norm_g[j], not last)
        x = x + mod_l[2] * o
        h = modulate(rmsnorm(x, norm_g[l, 1]), mod_l[3], mod_l[4])
        x = x + mod_l[5] * ec_moe(h, moe_router[l], moe_w1[l], moe_w3[l], moe_w2[l])
        if not last:
            xc = xc + mod_c[2] * oc
            hc = modulate(rmsnorm(xc, norm_g[l, 1]), mod_c[3], mod_c[4])
            xc = xc + mod_c[5] * ec_moe(hc, moe_router[l], moe_w1[l], moe_w3[l], moe_w2[l])
    return rmsnorm(x, final_g)
```

```cpp
#include <hip/hip_runtime.h>
#include <cstdio>
#include <cstdint>
#define LAS __attribute__((address_space(3)))

namespace pg8 {
#define PG8_LAS __attribute__((address_space(3)))
typedef unsigned short bf16_t;
typedef short bf16x8 __attribute__((ext_vector_type(8)));
typedef float f32x4 __attribute__((ext_vector_type(4)));
typedef unsigned u32x4 __attribute__((ext_vector_type(4)));
constexpr int BM = 256, BK = 64, HALF = 128, HTB = HALF * BK * 2  , STAGE_BYTES = 8 * HTB, NXCD = 8, WGM = 8;

__host__ __device__ __forceinline__ int lds_byte(int r, int c) { const int st = (r >> 4) * 2 + (c >> 5), rr = r & 15, cc = c & 31, ob = rr * 64 + cc * 2; return st * 1024 + (ob ^ (((ob >> 9) & 1) << 5)); }
__host__ __device__ __forceinline__ void stage_rc(int b, int& R, int& C) { const int st = b / 1024, sb = b % 1024, swz = sb ^ (((sb >> 9) & 1) << 5); R = (st >> 1) * 16 + swz / 64; C = (st & 1) * 32 + (swz % 64) / 2; }
__host__ __device__ __forceinline__ int perm32(int rho) { const int n = rho >> 4, i = rho & 15; return 8 * (i >> 2) + 4 * n + (i & 3); }

struct Unit { int pm, pn; };
struct Gemm { const bf16_t* A; const bf16_t* Bt; int M, N, K; };

struct StaticOrder {
    int nM, nN, nwg, G, c;
    __host__ __device__ void init(int M, int N, int G_, int c_) { nM = M / BM; nN = N / BM; nwg = nM * nN; G = G_; c = c_; }
    __host__ __device__ bool next(int i, Unit& u) const {
        const long L = (long)i * G + c; if (L >= nwg) return false;
        int wgid = (int)L; { const int q = nwg / NXCD, r = nwg % NXCD, xcd = wgid % NXCD, off = wgid / NXCD; wgid = (xcd < r ? xcd * (q + 1) : r * (q + 1) + (xcd - r) * q) + off; }
        const int nig = WGM * nN, gid = wgid / nig, fm = gid * WGM, gsz = (nM - fm) < WGM ? (nM - fm) : WGM;
        u.pm = fm + ((wgid % nig) % gsz); u.pn = (wgid % nig) / gsz; return true;
    }
    __device__ __forceinline__ void a_ready(const Unit&) const {}
    __device__ __forceinline__ void done(const Unit&) const {}
};


__device__ __forceinline__ unsigned cvt_pk_bf16(float lo, float hi) { unsigned r; asm volatile("v_cvt_pk_bf16_f32 %0, %1, %2" : "=v"(r) : "v"(lo), "v"(hi)); return r; }


struct EpiF32 {
    static constexpr bool PERM = false, AFTER_DRAIN = false;
    float* C; int ldc; int colmod;
    __device__ __forceinline__ void operator()(const f32x4 (&acc)[2][2][4][2], const Unit& u, int wr, int wc, int fr, int fq) const {
        const int row0 = u.pm * BM + wr * 64 + fr, col0 = (u.pn % colmod) * BM + wc * 32 + 4 * fq;
#pragma unroll
        for (int ai = 0; ai < 2; ++ai)
#pragma unroll
            for (int m = 0; m < 4; ++m) { float* rowp = C + (size_t)(row0 + ai * HALF + m * 16) * ldc + col0;
#pragma unroll
                for (int bj = 0; bj < 2; ++bj)
#pragma unroll
                    for (int n = 0; n < 2; ++n) *(f32x4*)(rowp + bj * HALF + n * 16) = acc[ai][bj][m][n]; }
    }
};
struct EpiResid {
    static constexpr bool PERM = true, AFTER_DRAIN = false;
    bf16_t* X; const float* xlat; const float* xctx; const float* mod; int colmod; int TLrows; int ldx;
    __device__ __forceinline__ void operator()(const f32x4 (&acc)[2][2][4][2], const Unit& u, int wr, int wc, int fr, int fq) const {
        const int row0 = u.pm * BM + wr * 64 + fr, col0 = (u.pn % colmod) * BM + wc * 32 + 8 * fq;
        const bool lat = u.pm * BM < TLrows;
        const int mrow = lat ? (u.pm >> 4) : 4;
        const float* md = mod + (size_t)mrow * 12288 + col0;
        const float* sbase = xlat ? (lat ? xlat : xctx - (size_t)TLrows * ldx) : nullptr;
#pragma unroll
        for (int bj = 0; bj < 2; ++bj) {
            const f32x4 g0 = *(const f32x4*)(md + bj * HALF), g1 = *(const f32x4*)(md + bj * HALF + 4);
#pragma unroll
            for (int ai = 0; ai < 2; ++ai)
#pragma unroll
                for (int m = 0; m < 4; ++m) {
                    const size_t o = (size_t)(row0 + ai * HALF + m * 16) * ldx + col0 + bj * HALF;
                    f32x4 s0, s1;
                    if (sbase) { s0 = *(const f32x4*)(sbase + o); s1 = *(const f32x4*)(sbase + o + 4); }
                    else { const u32x4 w = *(const u32x4*)(X + o);
                        s0 = (f32x4){__builtin_bit_cast(float, w.x << 16), __builtin_bit_cast(float, w.x & 0xffff0000u), __builtin_bit_cast(float, w.y << 16), __builtin_bit_cast(float, w.y & 0xffff0000u)};
                        s1 = (f32x4){__builtin_bit_cast(float, w.z << 16), __builtin_bit_cast(float, w.z & 0xffff0000u), __builtin_bit_cast(float, w.w << 16), __builtin_bit_cast(float, w.w & 0xffff0000u)}; }
                    const f32x4 r0 = s0 + g0 * acc[ai][bj][m][0], r1 = s1 + g1 * acc[ai][bj][m][1];
                    u32x4 w; w.x = cvt_pk_bf16(r0[0], r0[1]); w.y = cvt_pk_bf16(r0[2], r0[3]); w.z = cvt_pk_bf16(r1[0], r1[1]); w.w = cvt_pk_bf16(r1[2], r1[3]);
                    *(u32x4*)(X + o) = w;
                }
        }
    }
};
struct EpiBf16 {
    static constexpr bool PERM = true, AFTER_DRAIN = false;
    bf16_t* O; int ldc; int colmod;
    __device__ __forceinline__ void operator()(const f32x4 (&acc)[2][2][4][2], const Unit& u, int wr, int wc, int fr, int fq) const {
        const int row0 = u.pm * BM + wr * 64 + fr, col0 = (u.pn % colmod) * BM + wc * 32 + 8 * fq;
#pragma unroll
        for (int ai = 0; ai < 2; ++ai)
#pragma unroll
            for (int m = 0; m < 4; ++m) { bf16_t* rowp = O + (size_t)(row0 + ai * HALF + m * 16) * ldc + col0;
#pragma unroll
                for (int bj = 0; bj < 2; ++bj) { const f32x4 v0 = acc[ai][bj][m][0], v1 = acc[ai][bj][m][1];
                    u32x4 w; w.x = cvt_pk_bf16(v0[0], v0[1]); w.y = cvt_pk_bf16(v0[2], v0[3]); w.z = cvt_pk_bf16(v1[0], v1[1]); w.w = cvt_pk_bf16(v1[2], v1[3]);
                    *(u32x4*)(rowp + bj * HALF) = w; } }
    }
};
struct EpiSwiGLU {
    static constexpr bool PERM = true, AFTER_DRAIN = false;
    bf16_t* O; int ldc; int colmod;
    __device__ __forceinline__ void operator()(const f32x4 (&acc)[2][2][4][2], const Unit& u, int wr, int wc, int fr, int fq) const {
        const int row0 = u.pm * BM + wr * 64 + fr, col0 = (u.pn % colmod) * HALF + wc * 32 + 8 * fq;
#pragma unroll
        for (int ai = 0; ai < 2; ++ai)
#pragma unroll
            for (int m = 0; m < 4; ++m) { bf16_t* rowp = O + (size_t)(row0 + ai * HALF + m * 16) * ldc + col0;
                float h[8];
#pragma unroll
                for (int n = 0; n < 2; ++n)
#pragma unroll
                    for (int i = 0; i < 4; ++i) { const float g = acc[ai][0][m][n][i], v = acc[ai][1][m][n][i]; h[n * 4 + i] = g * __builtin_amdgcn_rcpf(1.0f + __expf(-g)) * v; }
                u32x4 w; w.x = cvt_pk_bf16(h[0], h[1]); w.y = cvt_pk_bf16(h[2], h[3]); w.z = cvt_pk_bf16(h[4], h[5]); w.w = cvt_pk_bf16(h[6], h[7]);
                *(u32x4*)rowp = w; }
    }
};
struct GroupOrder {
    int nM, nMs, nN, nE, nwg, G, c;
    const int* list; int lstride, nslots, zero_row;
    __device__ __forceinline__ int a_row(const Unit& u, int r) const { const int e = u.pm / nMs, slot = (u.pm - e * nMs) * BM + r; return slot < nslots ? list[e * lstride + slot] : zero_row; }
    __host__ __device__ void init(int nM_, int nMs_, int nN_, int nE_, int G_, int c_) { nM = nM_; nMs = nMs_; nN = nN_; nE = nE_; nwg = nM * nN * nE; G = G_; c = c_; }
    __host__ __device__ bool next(int i, Unit& u) const {
        const long L = (long)i * G + c; if (L >= nwg) return false;
        int wgid = (int)L; { const int q = nwg / NXCD, r = nwg % NXCD, xcd = wgid % NXCD, off = wgid / NXCD; wgid = (xcd < r ? xcd * (q + 1) : r * (q + 1) + (xcd - r) * q) + off; }
        const int per = nM * nN, e = wgid / per, r2 = wgid % per, tn = r2 / nM, tm = r2 % nM;
        u.pm = e * nMs + tm; u.pn = e * nN + tn; return true;
    }
    __device__ __forceinline__ void a_ready(const Unit&) const {}
    __device__ __forceinline__ void done(const Unit&) const {}
};

template <class Epi, class Sched, bool ALIGN_EPI = false, bool SP2 = false, bool GATHER = false>
__device__ __forceinline__ void gemm_phase(const int tid_in, PG8_LAS unsigned char* lds, const Gemm g, const Sched& S, const Epi& E) {
    const int tid = tid_in, wid = __builtin_amdgcn_readfirstlane(tid >> 6), lane = tid & 63, wr = wid >> 2, wc = wid & 3, fr = lane & 15, fq = lane >> 4;
    const int K = g.K, nt = K / BK;
    unsigned voffA[2], voffB[2]; int RA[2], CA[2];
#pragma unroll
    for (int i = 0; i < 2; ++i) { int R, C; stage_rc(tid * 16 + i * 8192, R, C); const int Rb = Epi::PERM ? ((R & ~31) + perm32(R & 31)) : R;
        voffA[i] = (unsigned)(R * K + C) * 2u; voffB[i] = (unsigned)(Rb * K + C) * 2u; RA[i] = R; CA[i] = C; }
    static_assert(!GATHER || SP2, "GATHER is wired into the SP2 loop only");
    unsigned gA[2][2] = {{0u, 0u}, {0u, 0u}}, gN[2][2] = {{0u, 0u}, {0u, 0u}};
#define PG8_GOFF(VO, un) do { _Pragma("unroll") for (int _h = 0; _h < 2; ++_h) _Pragma("unroll") for (int _i = 0; _i < 2; ++_i) \
        VO[_h][_i] = (unsigned)(S.a_row(un, _h * HALF + RA[_i]) * K + CA[_i]) * 2u; } while (0)
#define PG8_STAGE_G(bufoff, kbyte, VOH) do { _Pragma("unroll") for (int _i = 0; _i < 2; ++_i) \
        __builtin_amdgcn_global_load_lds((const unsigned*)((const char*)g.A + (kbyte) + (VOH)[_i]), (PG8_LAS unsigned*)(lds + (bufoff) + ldsw + _i * 8192), 16, 0, 0); } while (0)
    const size_t kstep = (size_t)(BK * 2);
    const size_t hstep = (size_t)HALF * K * 2;
    const size_t tstep = 2 * hstep;
    const unsigned ldsw = (unsigned)wid * 1024u;
    const int aoff = lds_byte(wr * 64 + fr, fq * 8), boff = lds_byte(wc * 32 + fr, fq * 8);
#define PG8_SA(b, h) (((b) * 2 + (h)) * HTB)
#define PG8_SB(b, h) ((4 + (b) * 2 + (h)) * HTB)
#define PG8_STAGE(bufoff, gbase, voff) do { _Pragma("unroll") for (int _i = 0; _i < 2; ++_i) \
        __builtin_amdgcn_global_load_lds((const unsigned*)((const char*)(gbase) + (voff)[_i]), (PG8_LAS unsigned*)(lds + (bufoff) + ldsw + _i * 8192), 16, 0, 0); } while (0)
#define PG8_LDA(dst, b, h) do { _Pragma("unroll") for (int m = 0; m < 4; ++m) _Pragma("unroll") for (int k = 0; k < 2; ++k) dst[m][k] = *(const PG8_LAS bf16x8*)(lds + PG8_SA(b, h) + aoff + m * 2048 + k * 1024); } while (0)
#define PG8_LDB(dst, b, h) do { _Pragma("unroll") for (int n = 0; n < 2; ++n) _Pragma("unroll") for (int k = 0; k < 2; ++k) dst[n][k] = *(const PG8_LAS bf16x8*)(lds + PG8_SB(b, h) + boff + n * 2048 + k * 1024); } while (0)
#define PG8_MMA(ai, bj, At, Bt) do { __builtin_amdgcn_s_setprio(1); _Pragma("unroll") for (int m = 0; m < 4; ++m) _Pragma("unroll") for (int n = 0; n < 2; ++n) _Pragma("unroll") for (int k = 0; k < 2; ++k) \
        acc[ai][bj][m][n] = __builtin_amdgcn_mfma_f32_16x16x32_bf16(Bt[n][k], At[m][k], acc[ai][bj][m][n], 0, 0, 0); __builtin_amdgcn_s_setprio(0); } while (0)
#define PG8_WAIT_V(n) asm volatile("s_waitcnt vmcnt(" #n ")" ::: "memory")
#define PG8_WAIT_L(n) asm volatile("s_waitcnt lgkmcnt(" #n ")" ::: "memory")
#define PG8_BAR __builtin_amdgcn_s_barrier()
#define PG8_SCHED __builtin_amdgcn_sched_barrier(0)
    Unit cur, nxt; int ui = 0;
    if (!S.next(0, cur)) return;
    f32x4 acc[2][2][4][2];
#pragma unroll
    for (int a = 0; a < 2; ++a)
#pragma unroll
        for (int b = 0; b < 2; ++b)
#pragma unroll
            for (int m = 0; m < 4; ++m)
#pragma unroll
                for (int n = 0; n < 2; ++n) acc[a][b][m][n] = (f32x4){0.f, 0.f, 0.f, 0.f};
    bf16x8 At[4][2], B0[2][2], B1[2][2];
    const char* cA = (const char*)g.A + (size_t)cur.pm * tstep; const char* cB = (const char*)g.Bt + (size_t)cur.pn * tstep;
    S.a_ready(cur);
    if constexpr (SP2) {
        if constexpr (GATHER) PG8_GOFF(gA, cur);
        PG8_STAGE(PG8_SB(0, 0), cB, voffB); PG8_STAGE(PG8_SB(0, 1), cB + hstep, voffB);
        if constexpr (GATHER) { PG8_STAGE_G(PG8_SA(0, 0), 0, gA[0]); PG8_STAGE_G(PG8_SA(0, 1), 0, gA[1]); } else { PG8_STAGE(PG8_SA(0, 0), cA, voffA); PG8_STAGE(PG8_SA(0, 1), cA + hstep, voffA); }
        if (wr == 1) PG8_BAR;
        PG8_WAIT_V(2); PG8_BAR;
        PG8_STAGE(PG8_SB(1, 0), cB + kstep, voffB);
        if constexpr (GATHER) PG8_STAGE_G(PG8_SA(1, 0), kstep, gA[0]); else PG8_STAGE(PG8_SA(1, 0), cA + kstep, voffA);
        PG8_STAGE(PG8_SB(1, 1), cB + hstep + kstep, voffB);
        PG8_WAIT_V(6); PG8_BAR;
    } else {
        PG8_STAGE(PG8_SB(0, 0), cB, voffB); PG8_STAGE(PG8_SA(0, 0), cA, voffA); PG8_STAGE(PG8_SB(0, 1), cB + hstep, voffB); PG8_STAGE(PG8_SA(0, 1), cA + hstep, voffA);
        if (wr == 1) PG8_BAR;
        PG8_WAIT_V(4); PG8_BAR;
        PG8_STAGE(PG8_SB(1, 0), cB + kstep, voffB); PG8_STAGE(PG8_SA(1, 0), cA + kstep, voffA); PG8_STAGE(PG8_SB(1, 1), cB + hstep + kstep, voffB);
        PG8_WAIT_V(6); PG8_BAR;
    }
    for (;;) {
        const bool has_next = S.next(ui + 1, nxt);
        const char* nA = has_next ? (const char*)g.A + (size_t)nxt.pm * tstep : cA; const char* nB = has_next ? (const char*)g.Bt + (size_t)nxt.pn * tstep : cB;
        if constexpr (GATHER) { if (has_next) PG8_GOFF(gN, nxt); else { _Pragma("unroll") for (int _h = 0; _h < 2; ++_h) _Pragma("unroll") for (int _i = 0; _i < 2; ++_i) gN[_h][_i] = gA[_h][_i]; } }
        for (int t = 0; t < nt; t += 2) {
            const bool last = (t == nt - 2);
            const char* a1 = cA + (size_t)(t + 1) * kstep;
            const char* a2 = last ? nA : cA + (size_t)(t + 2) * kstep; const char* b2 = last ? nB : cB + (size_t)(t + 2) * kstep;
            const char* a3 = a2 + kstep; const char* b3 = b2 + kstep;
            const size_t k1b = (size_t)(t + 1) * kstep, k2b = last ? 0 : (size_t)(t + 2) * kstep, k3b = k2b + kstep;
            unsigned g2[2][2];
            if constexpr (GATHER) { _Pragma("unroll") for (int _h = 0; _h < 2; ++_h) _Pragma("unroll") for (int _i = 0; _i < 2; ++_i) g2[_h][_i] = last ? gN[_h][_i] : gA[_h][_i]; }
            (void)k1b; (void)k2b; (void)k3b; (void)g2;
            if (last && has_next) S.a_ready(nxt);
            if constexpr (SP2) {
            PG8_LDB(B0, 0, 0); PG8_LDB(B1, 0, 1); PG8_SCHED; PG8_LDA(At, 0, 0); if constexpr (GATHER) PG8_STAGE_G(PG8_SA(1, 1), k1b, gA[1]); else PG8_STAGE(PG8_SA(1, 1), a1 + hstep, voffA);
            PG8_WAIT_V(8); PG8_WAIT_L(0); PG8_BAR; PG8_MMA(0, 0, At, B0); PG8_MMA(0, 1, At, B1); PG8_BAR; PG8_SCHED;
            PG8_LDA(At, 0, 1); PG8_STAGE(PG8_SB(0, 0), b2, voffB); PG8_STAGE(PG8_SB(0, 1), b2 + hstep, voffB); if constexpr (GATHER) PG8_STAGE_G(PG8_SA(0, 0), k2b, g2[0]); else PG8_STAGE(PG8_SA(0, 0), a2, voffA);
            PG8_WAIT_V(8); PG8_WAIT_L(0); PG8_BAR; PG8_MMA(1, 0, At, B0); PG8_MMA(1, 1, At, B1); PG8_BAR; PG8_SCHED;
            PG8_LDB(B0, 1, 0); PG8_LDB(B1, 1, 1); PG8_SCHED; PG8_LDA(At, 1, 0); if constexpr (GATHER) PG8_STAGE_G(PG8_SA(0, 1), k2b, g2[1]); else PG8_STAGE(PG8_SA(0, 1), a2 + hstep, voffA);
            PG8_WAIT_V(8); PG8_WAIT_L(0); PG8_BAR; PG8_MMA(0, 0, At, B0); PG8_MMA(0, 1, At, B1); PG8_BAR; PG8_SCHED;
            PG8_LDA(At, 1, 1); PG8_STAGE(PG8_SB(1, 0), b3, voffB); PG8_STAGE(PG8_SB(1, 1), b3 + hstep, voffB); if constexpr (GATHER) PG8_STAGE_G(PG8_SA(1, 0), k3b, g2[0]); else PG8_STAGE(PG8_SA(1, 0), a3, voffA);
            PG8_WAIT_V(8); PG8_WAIT_L(0); PG8_BAR; PG8_MMA(1, 0, At, B0); PG8_MMA(1, 1, At, B1); PG8_BAR; PG8_SCHED;
            } else {
            PG8_LDB(B0, 0, 0); PG8_SCHED; PG8_LDA(At, 0, 0); PG8_STAGE(PG8_SA(1, 1), a1 + hstep, voffA);
            PG8_WAIT_L(8); PG8_BAR; PG8_WAIT_L(0); PG8_MMA(0, 0, At, B0); PG8_BAR; PG8_SCHED;
            PG8_LDB(B1, 0, 1); PG8_STAGE(PG8_SB(0, 0), b2, voffB);
            PG8_BAR; PG8_WAIT_L(0); PG8_MMA(0, 1, At, B1); PG8_BAR;
            PG8_LDA(At, 0, 1); PG8_STAGE(PG8_SA(0, 0), a2, voffA);
            PG8_BAR; PG8_WAIT_L(0); PG8_MMA(1, 0, At, B0); PG8_BAR; PG8_SCHED;
            PG8_STAGE(PG8_SB(0, 1), b2 + hstep, voffB);
            PG8_WAIT_V(6); PG8_BAR; PG8_MMA(1, 1, At, B1); PG8_BAR;
            PG8_LDB(B0, 1, 0); PG8_SCHED; PG8_LDA(At, 1, 0); PG8_STAGE(PG8_SA(0, 1), a2 + hstep, voffA);
            PG8_WAIT_L(8); PG8_BAR; PG8_WAIT_L(0); PG8_MMA(0, 0, At, B0); PG8_BAR; PG8_SCHED;
            PG8_LDB(B1, 1, 1); PG8_STAGE(PG8_SB(1, 0), b3, voffB);
            PG8_BAR; PG8_WAIT_L(0); PG8_MMA(0, 1, At, B1); PG8_BAR;
            PG8_LDA(At, 1, 1); PG8_STAGE(PG8_SA(1, 0), a3, voffA);
            PG8_BAR; PG8_WAIT_L(0); PG8_MMA(1, 0, At, B0); PG8_BAR; PG8_SCHED;
            PG8_STAGE(PG8_SB(1, 1), b3 + hstep, voffB);
            PG8_WAIT_V(6); PG8_BAR; PG8_MMA(1, 1, At, B1); PG8_BAR;
            }
        }
        if constexpr (ALIGN_EPI) { if (wr == 0) PG8_BAR; }
        if constexpr (!Epi::AFTER_DRAIN) { E(acc, cur, wr, wc, fr, fq); S.done(cur); }
        if (!has_next) break;
#pragma unroll
        for (int a = 0; a < 2; ++a)
#pragma unroll
            for (int b = 0; b < 2; ++b)
#pragma unroll
                for (int m = 0; m < 4; ++m)
#pragma unroll
                    for (int n = 0; n < 2; ++n) acc[a][b][m][n] = (f32x4){0.f, 0.f, 0.f, 0.f};
        cur = nxt; cA = nA; cB = nB; ++ui;
        if constexpr (GATHER) { _Pragma("unroll") for (int _h = 0; _h < 2; ++_h) _Pragma("unroll") for (int _i = 0; _i < 2; ++_i) gA[_h][_i] = gN[_h][_i]; }
        if constexpr (ALIGN_EPI) { if (wr == 1) PG8_BAR; }
    }
    PG8_WAIT_V(0);
    if constexpr (!ALIGN_EPI) { if (wr == 0) PG8_BAR; }
    PG8_BAR;
    if constexpr (Epi::AFTER_DRAIN) { E.fused(acc, cur, wr, wc, fr, fq, lds, wid, lane); S.done(cur); }
#undef PG8_GOFF
#undef PG8_STAGE_G
#undef PG8_SA
#undef PG8_SB
#undef PG8_STAGE
#undef PG8_LDA
#undef PG8_LDB
#undef PG8_MMA
#undef PG8_WAIT_V
#undef PG8_WAIT_L
#undef PG8_BAR
#undef PG8_SCHED
}
}

#define XB_TMO      128
#define XB_XCNT(j)  (256  + 64 * (j))
#define XB_XSUB(j)  (1280 + 64 * (j))
#define XB_XGEN(j)  (2304 + 64 * (j))
#define XB_TOP      3328
#define XB_TOPGEN   3392
#define XCD_BAR_WORDS 3456
#define XB_SPIN_CAP (1u << 18)

__device__ __forceinline__ unsigned xb_ld(unsigned* p)              { return __hip_atomic_load(p, __ATOMIC_RELAXED, __HIP_MEMORY_SCOPE_AGENT); }
__device__ __forceinline__ unsigned xb_add(unsigned* p, unsigned v) { return __hip_atomic_fetch_add(p, v, __ATOMIC_RELAXED, __HIP_MEMORY_SCOPE_AGENT); }
__device__ __forceinline__ unsigned xb_xcc_id() { return (unsigned)__builtin_amdgcn_s_getreg((3 << 11) | 20) & 0xFu; }
#define XB_SPIN(cond, bar) do { unsigned _sp = 0; while (cond) { __builtin_amdgcn_s_sleep(1); \
    if ((++_sp & 255u) == 0u) { if (xb_ld(&(bar)[XB_TMO])) break; if (_sp > XB_SPIN_CAP) { atomicAdd(&(bar)[XB_TMO], 1u); break; } } } } while (0)

struct XcdBarrier {
    unsigned* bar; unsigned x;
    volatile LAS unsigned* st;
};

__device__ __forceinline__ XcdBarrier xcd_barrier_post(unsigned* bar, volatile LAS unsigned* st) {
    XcdBarrier b; b.bar = bar; b.x = xb_xcc_id(); b.st = st;
    if (threadIdx.x == 0) (void)xb_add(&bar[XB_XCNT(b.x)], 1u);
    return b;
}
__device__ __forceinline__ void xcd_barrier_complete(unsigned* bar, unsigned x, unsigned& nloc, unsigned& nx) {
    const unsigned G = gridDim.x * gridDim.y * gridDim.z;
    unsigned sum, cnt, mine, sp = 0u;
    for (;;) {
        sum = 0u; cnt = 0u; mine = 0u;
#pragma unroll
        for (unsigned j = 0; j < 16; ++j) { const unsigned c = xb_ld(&bar[XB_XCNT(j)]); sum += c; cnt += (c > 0u) ? 1u : 0u; mine = (j == x) ? c : mine; }
        if (sum == G) break;
        __builtin_amdgcn_s_sleep(1);
        if ((++sp & 255u) == 0u) { if (xb_ld(&bar[XB_TMO])) break; if (sp > XB_SPIN_CAP) { atomicAdd(&bar[XB_TMO], 1u); break; } }
    }
    nloc = mine > 0u ? mine : 1u; nx = cnt > 0u ? cnt : 1u;
}

__device__ __forceinline__ void xcd_barrier(const XcdBarrier& b, const int tid_) {
    asm volatile("s_waitcnt vmcnt(0)" ::: "memory");
    __syncthreads();
    if (tid_ == 0) {
        unsigned* bar = b.bar;
        __builtin_amdgcn_s_waitcnt(0);
        unsigned nloc = b.st[0], nx = b.st[1];
        if (nloc == 0u) { xcd_barrier_complete(bar, b.x, nloc, nx); b.st[0] = nloc; b.st[1] = nx; }
        const unsigned old = xb_add(&bar[XB_XSUB(b.x)], 1u);
        const unsigned gen = old / nloc;
        if (old + 1u == (gen + 1u) * nloc) {
            __builtin_amdgcn_fence(__ATOMIC_RELEASE, "agent");
            asm volatile("s_waitcnt vmcnt(0)" ::: "memory");
            const unsigned og = xb_add(&bar[XB_TOP], 1u);
            const unsigned tg = og / nx;
            if (og + 1u == (tg + 1u) * nx) xb_add(&bar[XB_TOPGEN], 1u);
            else XB_SPIN(xb_ld(&bar[XB_TOPGEN]) == tg, bar);
            __builtin_amdgcn_fence(__ATOMIC_ACQUIRE, "agent");
            xb_add(&bar[XB_XGEN(b.x)], 1u);
            asm volatile("s_waitcnt vmcnt(0)" ::: "memory");
        } else {
            XB_SPIN(xb_ld(&bar[XB_XGEN(b.x)]) == gen, bar);
            __builtin_amdgcn_fence(__ATOMIC_ACQUIRE, "agent");
            asm volatile("s_waitcnt vmcnt(0)" ::: "memory");
        }
    }
    __syncthreads();
}


namespace {
#define GAS __attribute__((address_space(1)))
typedef unsigned short bf16;
typedef unsigned v4u __attribute__((ext_vector_type(4)));
typedef unsigned v2u __attribute__((ext_vector_type(2)));
typedef short bf16x8_t __attribute__((ext_vector_type(8)));
typedef float f32x4_t __attribute__((ext_vector_type(4)));
typedef float f32x2_t __attribute__((ext_vector_type(2)));

constexpr int D = 2048, NB = 4, SEQ = 4096, CTXL = 256, G = 1024;
constexpr int TL = NB * SEQ, TC = NB * CTXL, T = TL + TC;
constexpr int NE = 16, ME = 2176, MEP = 2304;
constexpr int NT = 512, NWAVES = 8;
constexpr float EPS = 1e-6f;
constexpr int RING_BYTES = 131072, LDSCTL_OFF = RING_BYTES, MISC_OFF = LDSCTL_OFF + 320, LDS_BYTES = 147456;
constexpr size_t CTL_BYTES = 1u << 20;
constexpr int CW_BAR = 4096;
#ifndef MK_PER_PHASE
#define MK_PER_PHASE 0
#endif
constexpr int NPHASES = 22;
#ifndef PG8_SP2
#define PG8_SP2 true
#endif
#ifndef PG8_ALIGN
#define PG8_ALIGN true
#endif

struct Args {
    const float *x, *c, *ctx, *c_ctx, *ada_w, *ada_b, *norm_g, *final_g, *ab_w_in, *ab_w_out,
        *conf_dw_w, *conf_dw_b, *conf_ln_g, *conf_ln_b, *lru_conv_w, *lru_conv_b, *lru_wa, *lru_ba,
        *lru_wi, *lru_bi, *lru_lam, *cd_w_in, *cd_w_out, *na_bias, *hgrn_lb, *hgrn_norm_g,
        *moe_router, *moe_w1, *moe_w3, *moe_w2;
    float* out;
    unsigned* ctl;
    bf16 *WinT0, *WoutT0, *WinT1, *WoutT1, *WupT, *WdnT;
    float *X, *MOD, *AFF, *GATEV;
    int *SLOTOF, *LIST;
    bf16 *H, *CAT, *XS, *HID, *Z16, *VT, *VT6, *Y16, *QT, *KT, *KHT, *RTH, *RTL;
    float *Z, *O, *U, *XL, *AF, *BF, *AB, *BB, *OF, *OB, *Y, *TSP, *TSH, *CIN, *DEC, *RBIAS;
    int ph_lo, ph_hi;
};

__device__ __forceinline__ int fresh_tid(int wid) { int l; asm volatile("v_mbcnt_lo_u32_b32 %0, -1, 0\n\tv_mbcnt_hi_u32_b32 %0, -1, %0" : "=v"(l)); return wid * 64 + l; }
__device__ __forceinline__ float sigmoidf_(float v) { return __builtin_amdgcn_rcpf(1.0f + __expf(-v)); }
__device__ __forceinline__ float siluf_(float v) { return v * __builtin_amdgcn_rcpf(1.0f + __expf(-v)); }
__device__ __forceinline__ float wave_sum(float v) {
#pragma unroll
    for (int o = 32; o >= 1; o >>= 1) v += __shfl_xor(v, o, 64);
    return v;
}
typedef __bf16 bf16x2v_t __attribute__((ext_vector_type(2)));
__device__ __forceinline__ unsigned cvtpk(float lo, float hi) { const f32x2_t v = {lo, hi}; const bf16x2v_t b = __builtin_convertvector(v, bf16x2v_t); return __builtin_bit_cast(unsigned, b); }
__device__ __forceinline__ unsigned f2bf(float f) { return cvtpk(f, 0.f) & 0xffffu; }
__device__ __forceinline__ float bf2f(bf16 v) { return __builtin_bit_cast(float, (unsigned)v << 16); }
__device__ __forceinline__ unsigned pk2(float lo, float hi) { return cvtpk(lo, hi); }
__device__ __forceinline__ float4 ldx4(const bf16* q) { const v2u w = *(const v2u*)q; return make_float4(__builtin_bit_cast(float, w.x << 16), __builtin_bit_cast(float, w.x & 0xffff0000u), __builtin_bit_cast(float, w.y << 16), __builtin_bit_cast(float, w.y & 0xffff0000u)); }
__device__ __forceinline__ void stx4(bf16* q, const float4 v) { v2u o; o.x = pk2(v.x, v.y); o.y = pk2(v.z, v.w); *(v2u*)q = o; }
__device__ __forceinline__ int mod_row(int row) { return row < TL ? (row >> 12) : 4; }
__device__ __forceinline__ void seq_pos(int row, int& n, int& len) {
    if (row < TL) { n = row & (SEQ - 1); len = SEQ; } else { n = (row - TL) & (CTXL - 1); len = CTXL; }
}

__device__ __forceinline__ void transpose_item(const float* W, int K, int N, bf16* WT, int k0, int n0, int drow0, float* scr, int lane) {
#pragma unroll 8
    for (int i = 0; i < 32; ++i) { const int kk = 2 * i + (lane >> 5); scr[kk * 33 + (lane & 31)] = __builtin_nontemporal_load(W + (size_t)(k0 + kk) * N + n0 + (lane & 31)); }
    asm volatile("s_waitcnt lgkmcnt(0)" ::: "memory");
    const int c = lane & 7;
#pragma unroll
    for (int j = 0; j < 4; ++j) { const int n = (lane >> 3) + 8 * j; const float* s = scr + (8 * c) * 33 + n;
        v4u o; o.x = pk2(s[0 * 33], s[1 * 33]); o.y = pk2(s[2 * 33], s[3 * 33]); o.z = pk2(s[4 * 33], s[5 * 33]); o.w = pk2(s[6 * 33], s[7 * 33]);
        __builtin_nontemporal_store(o, (v4u*)(WT + (size_t)(drow0 + n) * K + k0 + 8 * c)); }
    asm volatile("s_waitcnt lgkmcnt(0)" ::: "memory");
}
__device__ __forceinline__ void st_weights(const int tid_, const Args& p, float* lds) {
    const int lane = tid_ & 63, w = tid_ >> 6, gw = blockIdx.x * NWAVES + w, ngw = gridDim.x * NWAVES;
    float* scr = lds + w * 4096;
    constexpr int I_SQ = 32 * 64;
    constexpr int I_MOE = 2 * NE * 3 * I_SQ;
    constexpr int I_IN0 = 32 * 128, I_IN1 = 32 * 256;
    constexpr int NITEMS = I_MOE + I_IN0 + I_SQ + I_IN1 + I_SQ;
    for (int it = gw; it < NITEMS; it += ngw) {
        int r = it;
        if (r < I_MOE) {
            const int mat = r / I_SQ, ii = r % I_SQ, l = mat / 48, e = (mat % 48) / 3, which = mat % 3;
            const int kb = ii / 64, nb = ii % 64, k0 = kb * 64, n0 = nb * 32;
            const size_t wo = ((size_t)l * NE + e) * D * D;
            if (which == 2) transpose_item(p.moe_w2 + wo, D, D, p.WdnT + wo, k0, n0, n0, scr, lane);
            else {
                const int drow0 = 256 * (n0 >> 7) + (n0 & 127) + (which ? 128 : 0);
                transpose_item((which ? p.moe_w3 : p.moe_w1) + wo, D, D, p.WupT + 2 * wo, k0, n0, drow0, scr, lane);
            }
            continue;
        }
        r -= I_MOE;
        if (r < I_IN0) { const int kb = r / 128, nb = r % 128; transpose_item(p.ab_w_in, D, 4096, p.WinT0, kb * 64, nb * 32, nb * 32, scr, lane); continue; }
        r -= I_IN0;
        if (r < I_SQ) { const int kb = r / 64, nb = r % 64; transpose_item(p.ab_w_out, D, D, p.WoutT0, kb * 64, nb * 32, nb * 32, scr, lane); continue; }
        r -= I_SQ;
        if (r < I_IN1) { const int kb = r / 256, nb = r % 256; transpose_item(p.cd_w_in, D, 8192, p.WinT1, kb * 64, nb * 32, nb * 32, scr, lane); continue; }
        r -= I_IN1;
        { const int kb = r / 64, nb = r % 64; transpose_item(p.cd_w_out, D, D, p.WoutT1, kb * 64, nb * 32, nb * 32, scr, lane); }
    }
}
__device__ __forceinline__ void st_init(const int tid_, const Args& p) {
    const size_t n4 = (size_t)T * D / 4, nl4 = (size_t)TL * D / 4;
    for (size_t i = (size_t)blockIdx.x * NT + tid_; i < n4; i += (size_t)gridDim.x * NT) {
        float4 v = i < nl4 ? ((const float4*)p.x)[i] : ((const float4*)p.ctx)[i - nl4];
        ((float4*)p.X)[i] = v;
    }
}
__device__ __forceinline__ void st_ada(const int tid_, const Args& p, float* lds) {
    const int tid = tid_, lane = tid & 63, w = tid >> 6;
    float* sl = lds;
    float* red = lds + 5 * D;
    __syncthreads();
    for (int i = tid; i < 5 * D; i += NT) { const int r = i >> 11, k = i & (D - 1); sl[i] = siluf_(r < 4 ? p.c[r * D + k] : p.c_ctx[k]); }
    __syncthreads();
    for (int u = blockIdx.x; u < 384; u += gridDim.x) {
        const int l = u / 192, j = (u % 192) * 64 + lane;
        const float* W = p.ada_w + (size_t)l * D * 12288 + j;
        float acc[5] = {0.f, 0.f, 0.f, 0.f, 0.f};
#pragma unroll 16
        for (int k = w * 256; k < (w + 1) * 256; ++k) {
            const float wv = __builtin_nontemporal_load(W + (size_t)k * 12288);
#pragma unroll
            for (int r = 0; r < 5; ++r) acc[r] += sl[r * D + k] * wv;
        }
        __syncthreads();
#pragma unroll
        for (int r = 0; r < 5; ++r) red[(w * 5 + r) * 64 + lane] = acc[r];
        __syncthreads();
        if (tid < 320) {
            const int r = tid >> 6;
            float sum = 0.f;
            for (int ww = 0; ww < 8; ++ww) sum += red[(ww * 5 + r) * 64 + lane];
            p.MOD[((size_t)l * 5 + r) * 12288 + j] = sum + p.ada_b[l * 12288 + j];
        }
    }
    __syncthreads();
}

__device__ __forceinline__ void st_norm_mod(const int tid_, const Args& p, int l, int nrows, int which = 0, int b0 = 0) {
    if ((int)blockIdx.x < b0) return;
    const int lane = tid_ & 63, gw = ((int)blockIdx.x - b0) * NWAVES + (tid_ >> 6), nw = ((int)gridDim.x - b0) * NWAVES;
    const float* g = p.norm_g + (size_t)(l * 2 + which) * D;
    for (int row = gw; row < nrows; row += nw) {
        const bool fromX = !(l == 0 && which == 0);
        const float* xr = row < TL ? p.x + (size_t)row * D : p.ctx + (size_t)(row - TL) * D;
        const float* md = p.MOD + ((size_t)l * 5 + mod_row(row)) * 12288 + (which ? 3 * D : 0);
        float4 v[8];
        float ss = 0.f;
#pragma unroll
        for (int i = 0; i < 8; ++i) { v[i] = fromX ? ldx4((const bf16*)p.X + (size_t)row * D + (lane + 64 * i) * 4) : ((const float4*)xr)[lane + 64 * i]; ss += v[i].x * v[i].x + v[i].y * v[i].y + v[i].z * v[i].z + v[i].w * v[i].w; }
        ss = wave_sum(ss);
        const float rs = 1.0f / sqrtf(ss / D + EPS);
#pragma unroll
        for (int i = 0; i < 8; ++i) {
            const int j = (lane + 64 * i) * 4;
            const float4 gg = *(const float4*)(g + j), sh = *(const float4*)(md + j), sc = *(const float4*)(md + D + j);
            v2u o;
            o.x = pk2(v[i].x * rs * gg.x * (1.f + sc.x) + sh.x, v[i].y * rs * gg.y * (1.f + sc.y) + sh.y);
            o.y = pk2(v[i].z * rs * gg.z * (1.f + sc.z) + sh.z, v[i].w * rs * gg.w * (1.f + sc.w) + sh.w);
            *(v2u*)(p.H + (size_t)row * D + j) = o;
        }
    }
}

__device__ __forceinline__ void st_l0_pre(const int tid_, const Args& p) {
    const size_t n = (size_t)T * 128;
#pragma unroll 2
    for (size_t idx = (size_t)blockIdx.x * NT + tid_; idx < n; idx += (size_t)gridDim.x * NT) {
        const size_t row = idx >> 7; const int c8 = (int)(idx & 127) * 8;
        const v4u a = *(const v4u*)(p.Z16 + row * 4096 + c8), gt = *(const v4u*)(p.Z16 + row * 4096 + 1024 + c8);
        const unsigned aw[4] = {a.x, a.y, a.z, a.w}, gw_[4] = {gt.x, gt.y, gt.z, gt.w};
        float o[8];
#pragma unroll
        for (int q = 0; q < 4; ++q) {
            const float a0 = __builtin_bit_cast(float, aw[q] << 16), a1 = __builtin_bit_cast(float, aw[q] & 0xffff0000u);
            const float g0 = __builtin_bit_cast(float, gw_[q] << 16), g1 = __builtin_bit_cast(float, gw_[q] & 0xffff0000u);
            o[2 * q] = a0 * __builtin_amdgcn_rcpf(1.0f + __expf(-g0)); o[2 * q + 1] = a1 * __builtin_amdgcn_rcpf(1.0f + __expf(-g1));
        }
        v4u u; u.x = cvtpk(o[0], o[1]); u.y = cvtpk(o[2], o[3]); u.z = cvtpk(o[4], o[5]); u.w = cvtpk(o[6], o[7]);
        *(v4u*)((bf16*)p.U + row * 1024 + c8) = u;
    }
}
template <int RR, int TT>
__device__ __forceinline__ void conf_row_steps(const Args& p, float (&v)[2][TT], const float (&wk)[2][31], int n0, int len, int row0, int c0) {
    if constexpr (RR < TT + 30) {
        const int m = n0 - 15 + RR;
        const bool inseq = (m >= 0 && m < len);
        const unsigned up = *(const unsigned*)((const bf16*)p.U + (size_t)(inseq ? row0 - 15 + RR : row0) * 1024 + c0);
        float2 uu; uu.x = inseq ? __builtin_bit_cast(float, up << 16) : 0.f; uu.y = inseq ? __builtin_bit_cast(float, up & 0xffff0000u) : 0.f;
#pragma unroll
        for (int k = 0; k < 31; ++k) {
            const int t = RR - k;
            if (t >= 0 && t < TT) { v[0][t] += wk[0][k] * uu.x; v[1][t] += wk[1][k] * uu.y; }
        }
        conf_row_steps<RR + 1, TT>(p, v, wk, n0, len, row0, c0);
    }
}
__device__ __forceinline__ void st_l0_conf(const int tid_, const Args& p, float* lds) {
    constexpr int TT = 16;
    const int tid = tid_, lane = tid & 63, w = tid >> 6, c0 = 2 * tid;
    float* part = lds;
    float* stat = lds + 256;
    float wk[2][31];
#pragma unroll
    for (int k = 0; k < 31; ++k) { const float2 ww = *(const float2*)(p.conf_dw_w + k * 1024 + c0); wk[0][k] = ww.x; wk[1][k] = ww.y; }
    const float2 bias = *(const float2*)(p.conf_dw_b + c0), gg = *(const float2*)(p.conf_ln_g + c0), bb = *(const float2*)(p.conf_ln_b + c0);
    for (int u = blockIdx.x; u < T / TT; u += gridDim.x) {
        const int row0 = u * TT;
        int n0, len; seq_pos(row0, n0, len);
        float v[2][TT];
#pragma unroll
        for (int t = 0; t < TT; ++t) { v[0][t] = bias.x; v[1][t] = bias.y; }
        conf_row_steps<0, TT>(p, v, wk, n0, len, row0, c0);
        float a[2 * TT];
#pragma unroll
        for (int t = 0; t < TT; ++t) { a[t] = v[0][t] + v[1][t]; a[TT + t] = v[0][t] * v[0][t] + v[1][t] * v[1][t]; }
#pragma unroll
        for (int st = 0; st < 5; ++st) {
            const int half = TT >> st;
            const int bit = 32 >> st;
            const bool up = (lane & bit) != 0;
#pragma unroll
            for (int i = 0; i < half; ++i) {
                const float send = up ? a[i] : a[i + half];
                const float keep = up ? a[i + half] : a[i];
                a[i] = keep + __shfl_xor(send, bit, 64);
            }
        }
        a[0] += __shfl_xor(a[0], 1, 64);
        __syncthreads();
        if ((lane & 1) == 0) part[w * 32 + (lane >> 1)] = a[0];
        __syncthreads();
        if (tid < 32) {
            float sum = 0.f;
#pragma unroll
            for (int ww = 0; ww < 8; ++ww) sum += part[ww * 32 + tid];
            stat[tid] = sum;
        }
        __syncthreads();
#pragma unroll
        for (int t = 0; t < TT; ++t) {
            const float mu = stat[t] * (1.0f / 1024.0f);
            const float var = stat[TT + t] * (1.0f / 1024.0f) - mu * mu;
            const float rs = 1.0f / sqrtf(fmaxf(var, 0.f) + EPS);
            const float y0 = (v[0][t] - mu) * rs * gg.x + bb.x, y1 = (v[1][t] - mu) * rs * gg.y + bb.y;
            *(unsigned*)(p.CAT + (size_t)(row0 + t) * D + c0) = pk2(siluf_(y0), siluf_(y1));
        }
    }
    __syncthreads();
}
template <int DIR>
__device__ __forceinline__ void lru_epilogue(const Args& p, const f32x4_t (&pa)[4], const f32x4_t (&pi)[4], const float* xs, float bav, float biv, float spv,
                                             int li, int g, int jt, int h, int rt, int row0) {
    constexpr int dir = DIR;
        const int cj = 16 * jt + li, ch = h * 64 + cj;
        float pl[4][4], hl[4][4], segP[4], segH[4];
#pragma unroll
        for (int tt = 0; tt < 4; ++tt) {
            float av[4], bv[4];
#pragma unroll
            for (int e = 0; e < 4; ++e) {
                const float rr = sigmoidf_(pa[tt][e] + bav), ig = sigmoidf_(pi[tt][e] + biv);
                const float log_a = -8.0f * rr * spv;
                av[e] = __expf(log_a);
                const float x2 = 2.0f * log_a;
                const float em_s = -x2 * (1.0f + x2 * (0.5f + x2 * (0.16666667f + x2 * (0.041666668f + x2 * 0.0083333333f))));
                const float em = x2 > -0.1f ? em_s : 1.0f - __expf(x2);
                bv[e] = __builtin_amdgcn_sqrtf(em) * (ig * xs[(16 * tt + 4 * g + e) * 64 + cj]);
            }
            float P = 1.f, hh = 0.f;
#pragma unroll
            for (int q = 0; q < 4; ++q) { const int e = dir ? 3 - q : q; hh = av[e] * hh + bv[e]; P *= av[e]; hl[tt][e] = hh; pl[tt][e] = P; }
            segP[tt] = P; segH[tt] = hh;
        }
        float cP[4], cH[4];
        {
            float rP = 1.f, rH = 0.f;
#pragma unroll
            for (int q = 0; q < 16; ++q) {
                const int qq = dir ? 15 - q : q, tt = qq >> 2, gg = qq & 3;
                const float Pq = __shfl(segP[tt], li + 16 * gg, 64), Hq = __shfl(segH[tt], li + 16 * gg, 64);
                if (gg == g) { cP[tt] = rP; cH[tt] = rH; }
                rH = Pq * rH + Hq; rP *= Pq;
            }
        }
        unsigned* ABo = (unsigned*)(dir ? p.AB : p.AF);
#pragma unroll
        for (int tt = 0; tt < 4; ++tt)
#pragma unroll
            for (int e = 0; e < 4; ++e) {
                const int tok = 16 * tt + 4 * g + e;
                const size_t o = (size_t)(row0 + tok) * 1024 + ch;
                const float pc = pl[tt][e] * cP[tt], hloc = hl[tt][e] + pl[tt][e] * cH[tt];
                ABo[o] = cvtpk(pc, hloc);
                const bool last = dir ? (tok == 0) : (tok == 63);
                if (last) { p.TSP[((size_t)rt * 2 + dir) * 1024 + ch] = pc; p.TSH[((size_t)rt * 2 + dir) * 1024 + ch] = hloc; }
            }
}
__device__ __forceinline__ void st_l0_lru(const int tid_, const Args& p, float* lds) {
    const int tid = tid_, lane = tid & 63, w = __builtin_amdgcn_readfirstlane(tid >> 6), li = lane & 15, g = lane >> 4, j = tid & 63;
    const int dir = w >> 2, jt = w & 3;
    float* xs = lds;
    bf16* xsb = (bf16*)(lds + 4096);
    bf16* WT = (bf16*)(lds + 4096 + 2304);
    bf16* raw = (bf16*)(lds + 4096 + 2304 + 9216);
    const int nunits = (T / 64) * 16;
    int cur_h = -1;
    v4u raw0 = {0u, 0u, 0u, 0u}, raw1 = {0u, 0u, 0u, 0u}; bool have_raw = false;
    float cwv[4] = {0.f, 0.f, 0.f, 0.f}, cbv = 0.f, bav = 0.f, biv = 0.f, spv = 0.f;
    bf16x8_t wf[2][2];
    wf[0][0] = wf[0][1] = wf[1][0] = wf[1][1] = (bf16x8_t){0, 0, 0, 0, 0, 0, 0, 0};
#define LRU_FETCH(uu) do { const int h_ = (uu) & 15, row0_ = ((uu) >> 4) * 64; int n0_, len_; seq_pos(row0_, n0_, len_); \
        { const int r_ = tid >> 3, m_ = n0_ + r_ - 2; raw0 = (v4u){0u, 0u, 0u, 0u}; if (m_ >= 0 && m_ < len_) raw0 = *(const v4u*)(p.Z16 + (size_t)(row0_ + r_ - 2) * 4096 + 3072 + h_ * 64 + (tid & 7) * 8); } \
        if (tid < 24) { const int r_ = 64 + (tid >> 3), m_ = n0_ + r_ - 2; raw1 = (v4u){0u, 0u, 0u, 0u}; if (m_ >= 0 && m_ < len_) raw1 = *(const v4u*)(p.Z16 + (size_t)(row0_ + r_ - 2) * 4096 + 3072 + h_ * 64 + (tid & 7) * 8); } } while (0)
    for (int u = blockIdx.x; u < nunits; u += gridDim.x) {
        const int h = u & 15, rt = u >> 4, row0 = rt * 64;
        __syncthreads();
        if (h != cur_h) {
            for (int i = tid; i < 16384; i += NT) {
                const int s = i >> 12, o = i & 4095, d_ = s >> 1, ii = o >> 6, jj = o & 63;
                const float* src = (s & 1) ? p.lru_wi : p.lru_wa;
                WT[(s * 64 + jj) * 72 + ii] = (bf16)f2bf(src[(size_t)d_ * 16 * 4096 + h * 4096 + o]);
            }
            cur_h = h;
            const int chh = h * 64 + j;
#pragma unroll
            for (int k = 0; k < 4; ++k) cwv[k] = p.lru_conv_w[k * 1024 + chh];
            cbv = p.lru_conv_b[chh];
            const int che = h * 64 + 16 * jt + li;
            bav = p.lru_ba[dir * 1024 + che]; biv = p.lru_bi[dir * 1024 + che]; spv = log1pf(expf(-p.lru_lam[dir * 1024 + che]));
            __syncthreads();
#pragma unroll
            for (int s2 = 0; s2 < 2; ++s2)
#pragma unroll
                for (int ks = 0; ks < 2; ++ks) wf[s2][ks] = *(const bf16x8_t*)(WT + ((2 * dir + s2) * 64 + 16 * jt + li) * 72 + 32 * ks + 8 * g);
        }
        if (!have_raw) { LRU_FETCH(u); }
        {
            v4u* rt16 = (v4u*)raw;
            rt16[tid] = raw0; if (tid < 24) rt16[512 + tid] = raw1;
        }
        __syncthreads();
        { const int un = u + (int)gridDim.x; have_raw = un < nunits; if (have_raw) { LRU_FETCH(un); } }
        for (int i = tid; i < 4096; i += NT) {
            const int r = i >> 6, c = i & 63;
            float acc = cbv;
#pragma unroll
            for (int k = 0; k < 4; ++k) acc += cwv[k] * bf2f(raw[(r + k) * 64 + c]);
            xs[i] = acc;
            xsb[r * 72 + c] = (bf16)f2bf(acc);
        }
        __syncthreads();
        f32x4_t pa[4], pi[4];
#pragma unroll
        for (int tt = 0; tt < 4; ++tt) { pa[tt] = (f32x4_t){0.f, 0.f, 0.f, 0.f}; pi[tt] = (f32x4_t){0.f, 0.f, 0.f, 0.f}; }
#pragma unroll
        for (int tt = 0; tt < 4; ++tt)
#pragma unroll
            for (int ks = 0; ks < 2; ++ks) {
                const bf16x8_t xf = *(const bf16x8_t*)(xsb + (16 * tt + li) * 72 + 32 * ks + 8 * g);
                pa[tt] = __builtin_amdgcn_mfma_f32_16x16x32_bf16(xf, wf[0][ks], pa[tt], 0, 0, 0);
                pi[tt] = __builtin_amdgcn_mfma_f32_16x16x32_bf16(xf, wf[1][ks], pi[tt], 0, 0, 0);
            }
        if (dir) lru_epilogue<1>(p, pa, pi, xs, bav, biv, spv, li, g, jt, h, rt, row0); else lru_epilogue<0>(p, pa, pi, xs, bav, biv, spv, li, g, jt, h, rt, row0);
    }
    __syncthreads();
}
#undef LRU_FETCH
__device__ __forceinline__ void st_l0_carry(const int tid_, const Args& p) {
    const int tid = tid_;
    if (tid < 32) {
        for (int idx = blockIdx.x * 32 + tid; idx < 8192; idx += gridDim.x * 32) {
            const int ch = idx & 1023, b = (idx >> 10) & 3, dir = idx >> 12;
            float c = 0.f;
#pragma unroll 4
            for (int k = 0; k < 68; ++k) {
                int rt;
                if (dir == 0) rt = k < 4 ? (TL / 64 + b * 4 + k) : (b * 64 + (k - 4));
                else rt = k < 4 ? (TL / 64 + b * 4 + 3 - k) : (b * 64 + 63 - (k - 4));
                const size_t o = ((size_t)rt * 2 + dir) * 1024 + ch;
                p.CIN[o] = c;
                c = p.TSP[o] * c + p.TSH[o];
            }
        }
    }
}
__device__ __forceinline__ float gelu_tanh(float v) {
    const float u = 0.7978845608028654f * (v + 0.044715f * v * v * v);
    return v * __builtin_amdgcn_rcpf(1.0f + __expf(-2.0f * u));
}
__device__ __forceinline__ void st_l0_cat(const int tid_, const Args& p) {
    const size_t n = (size_t)T * 256;
#pragma unroll 2
    for (size_t idx = (size_t)blockIdx.x * NT + tid_; idx < n; idx += (size_t)gridDim.x * NT) {
        const size_t row = idx >> 8; const int c4 = (int)(idx & 255) * 4; const size_t rt = row >> 6;
        const v2u zy = *(const v2u*)(p.Z16 + row * 4096 + 2048 + c4);
        const float4 cf = *(const float4*)(p.CIN + (rt * 2 + 0) * 1024 + c4), cb = *(const float4*)(p.CIN + (rt * 2 + 1) * 1024 + c4);
        const size_t o = row * 1024 + c4;
        const v4u pf = *(const v4u*)((const unsigned*)p.AF + o), pb = *(const v4u*)((const unsigned*)p.AB + o);
        float4 af, bf, ab, bb;
        af.x = __builtin_bit_cast(float, pf.x << 16); bf.x = __builtin_bit_cast(float, pf.x & 0xffff0000u); af.y = __builtin_bit_cast(float, pf.y << 16); bf.y = __builtin_bit_cast(float, pf.y & 0xffff0000u);
        af.z = __builtin_bit_cast(float, pf.z << 16); bf.z = __builtin_bit_cast(float, pf.z & 0xffff0000u); af.w = __builtin_bit_cast(float, pf.w << 16); bf.w = __builtin_bit_cast(float, pf.w & 0xffff0000u);
        ab.x = __builtin_bit_cast(float, pb.x << 16); bb.x = __builtin_bit_cast(float, pb.x & 0xffff0000u); ab.y = __builtin_bit_cast(float, pb.y << 16); bb.y = __builtin_bit_cast(float, pb.y & 0xffff0000u);
        ab.z = __builtin_bit_cast(float, pb.z << 16); bb.z = __builtin_bit_cast(float, pb.z & 0xffff0000u); ab.w = __builtin_bit_cast(float, pb.w << 16); bb.w = __builtin_bit_cast(float, pb.w & 0xffff0000u);
        const float z0 = __builtin_bit_cast(float, zy.x << 16), z1 = __builtin_bit_cast(float, zy.x & 0xffff0000u), z2 = __builtin_bit_cast(float, zy.y << 16), z3 = __builtin_bit_cast(float, zy.y & 0xffff0000u);
        v2u r;
        r.x = pk2(gelu_tanh(z0) * (bf.x + af.x * cf.x + bb.x + ab.x * cb.x), gelu_tanh(z1) * (bf.y + af.y * cf.y + bb.y + ab.y * cb.y));
        r.y = pk2(gelu_tanh(z2) * (bf.z + af.z * cf.z + bb.z + ab.z * cb.z), gelu_tanh(z3) * (bf.w + af.w * cf.w + bb.w + ab.w * cb.w));
        *(v2u*)(p.CAT + row * D + 1024 + c4) = r;
    }
}

__device__ __forceinline__ void st_router_prep(const int tid_, const Args& p) {
    const int gt = blockIdx.x * NT + tid_, ngt = gridDim.x * NT;
    for (int i = gt; i < 2 * 5 * D; i += ngt) {
        const int j = i & (D - 1), m = (i >> 11) % 5, l = i / (5 * D);
        const float* md = p.MOD + ((size_t)l * 5 + m) * 12288;
        const float f = p.norm_g[(size_t)(l * 2 + 1) * D + j] * (1.0f + md[4 * D + j]);
        const float* r = p.moe_router + ((size_t)l * D + j) * NE;
#pragma unroll
        for (int e = 0; e < NE; ++e) {
            const float v = f * r[e];
            const unsigned hi = f2bf(v);
            const unsigned lo = f2bf(v - __builtin_bit_cast(float, hi << 16));
            const size_t o = (((size_t)l * 5 + m) * NE + e) * D + j;
            p.RTH[o] = (bf16)hi; p.RTL[o] = (bf16)lo;
        }
    }
    const int lane = tid_ & 63, gw = blockIdx.x * NWAVES + (tid_ >> 6), nw = gridDim.x * NWAVES;
    for (int u = gw; u < 2 * 5 * NE; u += nw) {
        const int e = u & 15, m = (u >> 4) % 5, l = u / 80;
        const float* md = p.MOD + ((size_t)l * 5 + m) * 12288 + 3 * D;
        float acc = 0.f;
        for (int j = lane; j < D; j += 64) acc += md[j] * p.moe_router[((size_t)l * D + j) * NE + e];
        acc = wave_sum(acc);
        if (lane == 0) p.RBIAS[u] = acc;
    }
}
__device__ __forceinline__ void st_post_mixer(const int tid_, const Args& p, int l, int nrows, float* lds) {
    (void)lds;
    const int lane = tid_ & 63, li = lane & 15, g = lane >> 4, gw = blockIdx.x * NWAVES + (tid_ >> 6), nw = gridDim.x * NWAVES;
    const float* gn = p.norm_g + (size_t)(l * 2 + 1) * D;
    for (int tile = gw; tile < nrows / 16; tile += nw) {
        const int row0 = tile * 16, m = mod_row(row0);
        const bf16* xr = (const bf16*)p.X + (size_t)(row0 + li) * D + 8 * g;
        const bf16* rh = p.RTH + (((size_t)l * 5 + m) * NE + li) * D + 8 * g;
        const bf16* rl = p.RTL + (((size_t)l * 5 + m) * NE + li) * D + 8 * g;
        f32x4_t acc0 = (f32x4_t){0.f, 0.f, 0.f, 0.f}, acc1 = acc0;
        float ss = 0.f;
#pragma unroll 8
        for (int ks = 0; ks < 64; ++ks) {
            const v4u xw = *(const v4u*)(xr + 32 * ks);
            const bf16x8_t bh = *(const bf16x8_t*)(rh + 32 * ks), bl = *(const bf16x8_t*)(rl + 32 * ks);
            const unsigned xq[4] = {xw.x, xw.y, xw.z, xw.w};
#pragma unroll
            for (int q = 0; q < 4; ++q) { const float x0 = __builtin_bit_cast(float, xq[q] << 16), x1 = __builtin_bit_cast(float, xq[q] & 0xffff0000u); ss += x0 * x0 + x1 * x1; }
            const bf16x8_t ah = __builtin_bit_cast(bf16x8_t, xw);
            acc0 = __builtin_amdgcn_mfma_f32_16x16x32_bf16(ah, bh, acc0, 0, 0, 0);
            acc1 = __builtin_amdgcn_mfma_f32_16x16x32_bf16(ah, bl, acc1, 0, 0, 0);
        }
        ss += __shfl_xor(ss, 16, 64); ss += __shfl_xor(ss, 32, 64);
        const float rs = 1.0f / sqrtf(ss / D + EPS);
        const float bias = p.RBIAS[(l * 5 + m) * NE + li];
        float lg[4];
#pragma unroll
        for (int i = 0; i < 4; ++i) lg[i] = (acc0[i] + acc1[i]) * __shfl(rs, 4 * g + i, 64) + bias;
#pragma unroll
        for (int i = 0; i < 4; ++i) {
            float mx = lg[i];
#pragma unroll
            for (int o = 8; o >= 1; o >>= 1) mx = fmaxf(mx, __shfl_xor(mx, o, 64));
            const float ev = expf(lg[i] - mx);
            float sum = ev;
#pragma unroll
            for (int o = 8; o >= 1; o >>= 1) sum += __shfl_xor(sum, o, 64);
            const size_t o = (size_t)(row0 + 4 * g + i) * NE + li;
            p.AFF[o] = ev / sum; p.SLOTOF[o] = -1;
        }
    }
}

template <int N, int CAP>
__device__ __forceinline__ void topk_sort_set(const int tid, const Args& p, unsigned long long* keys, int e, int row_base, int slot_base) {
    __syncthreads();
    for (int i = tid; i < N; i += NT) keys[i] = ((unsigned long long)__float_as_uint(p.AFF[(size_t)(row_base + i) * NE + e]) << 32) | (unsigned)(N - 1 - i);
    __syncthreads();
    for (int k = 2; k <= N; k <<= 1) {
        for (int j = k >> 1; j > 0; j >>= 1) {
            for (int t = tid; t < N / 2; t += NT) {
                const int i = ((t & ~(j - 1)) << 1) | (t & (j - 1)), l = i | j;
                const unsigned long long x = keys[i], y = keys[l];
                const bool desc = (i & k) == 0;
                if ((x < y) == desc) { keys[i] = y; keys[l] = x; }
            }
            __syncthreads();
        }
    }
    for (int i = tid; i < CAP; i += NT) {
        const unsigned long long key = keys[i];
        const int row = row_base + (N - 1 - (int)(unsigned)(key & 0xffffffffu)), slot = slot_base + i;
        p.LIST[e * ME + slot] = row; p.GATEV[e * ME + slot] = __uint_as_float((unsigned)(key >> 32)); p.SLOTOF[(size_t)row * NE + e] = slot;
    }
}
__device__ __forceinline__ void st_topk(const int tid_, const Args& p, bool with_ctx, float* lds) {
    unsigned long long* keys = (unsigned long long*)lds;
    const int nunits = with_ctx ? 128 : 64;
    for (int u = blockIdx.x; u < nunits; u += gridDim.x) {
        const int e = u & 15, b = (u >> 4) & 3;
        if (u < 64) topk_sort_set<SEQ, 512>(tid_, p, keys, e, b * SEQ, b * 512);
        else topk_sort_set<CTXL, 32>(tid_, p, keys, e, TL + b * CTXL, 2048 + b * 32);
    }
    __syncthreads();
}

__device__ __forceinline__ void st_gather(const int tid_, const Args& p, int nslots, int npad) {
    const int lane = tid_ & 63, gw = blockIdx.x * NWAVES + (tid_ >> 6), nw = gridDim.x * NWAVES;
    for (int u4 = gw; u4 < NE * npad / 4; u4 += nw) {
        const int u = u4 * 4, e = u / npad, slot0 = u % npad;
        int rows[4];
#pragma unroll
        for (int k = 0; k < 4; ++k) rows[k] = (slot0 + k < nslots) ? p.LIST[e * ME + slot0 + k] : -1;
        v4u v[4][4];
#pragma unroll
        for (int k = 0; k < 4; ++k) {
            const v4u* src = (const v4u*)(p.H + (size_t)(rows[k] < 0 ? 0 : rows[k]) * D);
#pragma unroll
            for (int i = 0; i < 4; ++i) v[k][i] = src[lane + 64 * i];
        }
#pragma unroll
        for (int k = 0; k < 4; ++k) {
            v4u* dst = (v4u*)(p.XS + ((size_t)e * MEP + slot0 + k) * D);
            const v4u z = {0u, 0u, 0u, 0u};
#pragma unroll
            for (int i = 0; i < 4; ++i) dst[lane + 64 * i] = rows[k] < 0 ? z : v[k][i];
        }
    }
}

template <bool FINAL>
__device__ __forceinline__ void st_combine(const int tid_, const Args& p, int l, int nrows) {
    const int lane = tid_ & 63, gw = blockIdx.x * NWAVES + (tid_ >> 6), nw = gridDim.x * NWAVES;
    int slot_n = -1; float gate_n = 0.f;
    if (gw < nrows && lane < NE) { slot_n = p.SLOTOF[(size_t)gw * NE + lane]; if (slot_n >= 0) gate_n = p.GATEV[lane * ME + slot_n]; }
    for (int row = gw; row < nrows; row += nw) {
        const int slot_v = slot_n; const float gate_v = gate_n;
        slot_n = -1; gate_n = 0.f;
        if (row + nw < nrows && lane < NE) { slot_n = p.SLOTOF[(size_t)(row + nw) * NE + lane]; if (slot_n >= 0) gate_n = p.GATEV[lane * ME + slot_n]; }
        const float* md = p.MOD + ((size_t)l * 5 + mod_row(row)) * 12288 + 5 * D;
        float4 acc[8];
#pragma unroll
        for (int i = 0; i < 8; ++i) acc[i] = make_float4(0.f, 0.f, 0.f, 0.f);
        unsigned long long mask = __ballot(slot_v >= 0);
        while (mask) {
            const int e = __builtin_ctzll(mask); mask &= mask - 1;
            const int slot = __builtin_amdgcn_readlane(slot_v, e);
            const float gt = __builtin_bit_cast(float, __builtin_amdgcn_readlane(__builtin_bit_cast(int, gate_v), e));
            const v2u* y = (const v2u*)(p.Y16 + ((size_t)e * MEP + slot) * D);
#pragma unroll
            for (int i = 0; i < 8; ++i) { const v2u yv = y[lane + 64 * i];
                acc[i].x += gt * __builtin_bit_cast(float, yv.x << 16); acc[i].y += gt * __builtin_bit_cast(float, yv.x & 0xffff0000u);
                acc[i].z += gt * __builtin_bit_cast(float, yv.y << 16); acc[i].w += gt * __builtin_bit_cast(float, yv.y & 0xffff0000u); }
        }
        bf16* xr = (bf16*)p.X + (size_t)row * D;
        float ss = 0.f;
#pragma unroll
        for (int i = 0; i < 8; ++i) {
            const float4 m = ((const float4*)md)[lane + 64 * i];
            float4 xv = ldx4(xr + (lane + 64 * i) * 4);
            xv.x += m.x * acc[i].x; xv.y += m.y * acc[i].y; xv.z += m.z * acc[i].z; xv.w += m.w * acc[i].w;
            if (FINAL) { acc[i] = xv; ss += xv.x * xv.x + xv.y * xv.y + xv.z * xv.z + xv.w * xv.w; }
            else stx4(xr + (lane + 64 * i) * 4, xv);
        }
        if (FINAL) {
            ss = wave_sum(ss);
            const float rs = 1.0f / sqrtf(ss / D + EPS);
#pragma unroll
            for (int i = 0; i < 8; ++i) {
                const float4 gg = ((const float4*)p.final_g)[lane + 64 * i];
                ((float4*)(p.out + (size_t)row * D))[lane + 64 * i] = make_float4(acc[i].x * rs * gg.x, acc[i].y * rs * gg.y, acc[i].z * rs * gg.z, acc[i].w * rs * gg.w);
            }
        }
    }
}

__device__ __forceinline__ void st_vt(const int tid_, const Args& p, float* lds, const int colgrp, bf16* dstT) {
    bf16* tile = (bf16*)lds;
    const int tid = tid_;
    for (int u = blockIdx.x; u < (T / 64) * 8; u += gridDim.x) {
        const int h = u & 7, rt = u >> 3, row0 = rt * 64;
        int b, key0;
        if (row0 < TL) { b = row0 >> 12; key0 = row0 & 4095; } else { b = (row0 - TL) >> 8; key0 = 4096 + ((row0 - TL) & 255); }
        __syncthreads();
        for (int i = tid; i < 1024; i += NT) {
            const int tok = i >> 4, c = i & 15;
            const v4u v = *(const v4u*)(p.Z16 + (size_t)(row0 + tok) * 8192 + colgrp * 1024 + h * 128 + c * 8);
            const unsigned wv[4] = {v.x, v.y, v.z, v.w};
#pragma unroll
            for (int q = 0; q < 4; ++q) { tile[(c * 8 + 2 * q) * 72 + tok] = (bf16)(wv[q] & 0xffffu); tile[(c * 8 + 2 * q + 1) * 72 + tok] = (bf16)(wv[q] >> 16); }
        }
        __syncthreads();
        for (int i = tid; i < 1024; i += NT) {
            const int d = i >> 3, c = i & 7;
            const v4u v = *(const v4u*)(tile + d * 72 + c * 8);
            *(v4u*)(dstT + (((size_t)(b * 8 + h) * 272 + (key0 >> 4) + (c >> 1)) * 128 + d) * 16 + (c & 1) * 8) = v;
        }
    }
    __syncthreads();
}
__device__ __forceinline__ float na_sel(int negbits, float x, int mbits, int bit) { const int m = (mbits << (31 - bit)) >> 31; return __builtin_bit_cast(float, (__builtin_bit_cast(int, x) & m) | (negbits & ~m)); }
__device__ __forceinline__ void st_na(const int tid_, const Args& p, float* lds) {
    const int tid = tid_, lane = tid & 63, w = __builtin_amdgcn_readfirstlane(tid >> 6), li = lane & 15, g = lane >> 4;
    const float scale2 = 0.08838834764831845f * 1.4426950408889634f;
    const int negbits = __builtin_bit_cast(int, -1.0e30f);
    const int half = w & 1, rq = w >> 1, q0col = half * 32, ct0 = half;
    int mbits = 0;
#pragma unroll
    for (int C = 0; C < 3; ++C)
#pragma unroll
        for (int qt = 0; qt < 2; ++qt) {
            const int qcol = q0col + 16 * qt + li; int c0q = qcol - 8; c0q = c0q < 0 ? 0 : (c0q > 48 ? 48 : c0q);
#pragma unroll
            for (int i = 0; i < 4; ++i) { const int kcol = 16 * (ct0 + C) + 4 * g + i; mbits |= ((kcol >= c0q) && (kcol < c0q + 16)) ? (1 << (8 * C + 4 * qt + i)) : 0; }
        }
    const bf16* Zb = p.Z16;
    const unsigned tlane = (unsigned)(4 * g - li + 18) * 16u;
    bf16* KL = (bf16*)((char*)lds + 24576);
    bf16* VL = KL + 2 * 64 * 136;
    const unsigned stlane = (unsigned)((tid >> 3) * 8192 + (tid & 7) * 8) * 2u;
    const unsigned kfrag = (unsigned)(li * 136 + 8 * g) * 2u, vfrag = (unsigned)(li * 16 + 4 * g) * 2u;
    for (int U = blockIdx.x; U < 512; U += gridDim.x) {
        const int b = U >> 7, h = (U >> 4) & 7, R = (U & 15) * 4;
        const int r = R + rq;
        int r0 = r - 4; r0 = r0 < 0 ? 0 : (r0 > 56 ? 56 : r0);
        int rho0 = R - 4; rho0 = rho0 < 0 ? 0 : (rho0 > 56 ? 56 : rho0);
        int rho1 = R - 1; rho1 = (rho1 < 0 ? 0 : (rho1 > 56 ? 56 : rho1)) + 7;
        const int nsteps = 4 + (rho1 - rho0 + 1);
        __syncthreads();
        for (int i = fresh_tid(w); i < 15 * 92; i += NT) {
            const int dr = i / 92, k = i - dr * 92 - 29;
            f32x4_t e;
#pragma unroll
            for (int ii = 0; ii < 4; ++ii) { const int d = k - 3 + ii; const int dcl = d < 0 ? 0 : (d > 30 ? 30 : d); const float v = p.na_bias[(h * 15 + dr) * 31 + dcl] * 1.4426950408889634f; e[ii] = (d >= 0 && d <= 30) ? v : 0.f; }
            *(f32x4_t*)(lds + i * 4) = e;
        }
        bf16x8_t Qf[2][4];
#pragma unroll
        for (int qt = 0; qt < 2; ++qt) {
            const unsigned qo = (unsigned)((b * SEQ + r * 64 + q0col + 16 * qt + li) * 8192 + h * 128 + 8 * g) * 2u;
#pragma unroll
            for (int ds = 0; ds < 4; ++ds) Qf[qt][ds] = *(const bf16x8_t*)((const char*)Zb + qo + 64 * ds);
        }
        f32x4_t O[8][2];
#pragma unroll
        for (int dt = 0; dt < 8; ++dt) { O[dt][0] = (f32x4_t){0.f, 0.f, 0.f, 0.f}; O[dt][1] = (f32x4_t){0.f, 0.f, 0.f, 0.f}; }
        float lsum[2] = {0.f, 0.f}, mref[2] = {0.f, 0.f};
        const bf16* VTg = p.VT + (size_t)(b * 8 + h) * 272 * 2048;
        const char* tabu = (const char*)lds + (29 - 16 * half) * 16 - 256;
        v4u skA0, skA1, svA0, svA1, skB0, skB1, svB0, svB1;
#define NA_FETCH(s_, sk0, sk1, sv0, sv1) do { const int s__ = (s_); int krow_, kt_; \
            if (s__ < 4) { krow_ = TL + b * CTXL + 64 * s__; kt_ = 256 + 4 * s__; } else { const int rho_ = rho0 + s__ - 4; krow_ = b * SEQ + rho_ * 64; kt_ = rho_ * 4; } \
            unsigned so_ = stlane; asm volatile("" : "+v"(so_));        \
            const char* ks_ = (const char*)Zb + ((size_t)krow_ * 8192 + 1024 + h * 128) * 2; \
            sk0 = *(const v4u*)(ks_ + so_); sk1 = *(const v4u*)(ks_ + so_ + 128); \
            unsigned vo_ = (unsigned)tid * 16u; asm volatile("" : "+v"(vo_)); \
            const char* vs_ = (const char*)VTg + (size_t)kt_ * 4096; sv0 = *(const v4u*)(vs_ + vo_); sv1 = *(const v4u*)(vs_ + vo_ + 8192); } while (0)
#define NA_PUT(buf_, sk0, sk1, sv0, sv1) do { bf16* kd_ = KL + (buf_) * 64 * 136 + (tid >> 3) * 136 + (tid & 7) * 8; *(v4u*)kd_ = sk0; *(v4u*)(kd_ + 64) = sk1; \
            v4u* vd_ = (v4u*)(VL + (buf_) * 8192); vd_[tid] = sv0; vd_[tid + 512] = sv1; } while (0)
#define NA_TILES(buf_, t0_, t1_, KIND_, drow_, first_) do { \
            const char* kb_ = (const char*)KL + (buf_) * (64 * 136 * 2) + kfrag; const char* vb_ = (const char*)VL + (buf_) * 16384 + vfrag; \
            f32x4_t S[2][2]; \
            _Pragma("unroll") for (int t = 0; t < 2; ++t) { S[t][0] = (f32x4_t){0.f, 0.f, 0.f, 0.f}; S[t][1] = (f32x4_t){0.f, 0.f, 0.f, 0.f}; } \
            _Pragma("unroll") for (int t = 0; t < ((KIND_) == 2 ? 1 : 2); ++t) { const int tl_ = t ? (t1_) : (t0_); \
                _Pragma("unroll") for (int ds = 0; ds < 4; ++ds) { const bf16x8_t kf = *(const bf16x8_t*)(kb_ + tl_ * (16 * 136 * 2) + 64 * ds); \
                    S[t][0] = __builtin_amdgcn_mfma_f32_16x16x32_bf16(kf, Qf[0][ds], S[t][0], 0, 0, 0); \
                    S[t][1] = __builtin_amdgcn_mfma_f32_16x16x32_bf16(kf, Qf[1][ds], S[t][1], 0, 0, 0); } } \
            float pv[2][2][4]; \
            if ((KIND_) != 0) { const char* tb_ = tabu + (drow_) * 1472 + tlane; int mb_ = mbits; asm volatile("" : "+v"(mb_));     \
                _Pragma("unroll") for (int t = 0; t < ((KIND_) == 2 ? 1 : 2); ++t) _Pragma("unroll") for (int qt = 0; qt < 2; ++qt) { const int C_ = (KIND_) == 2 ? 2 : t; \
                    const f32x4_t bias_ = *(const f32x4_t*)(tb_ + (C_ - qt + 1) * 256); \
                    _Pragma("unroll") for (int i = 0; i < 4; ++i) pv[t][qt][i] = na_sel(negbits, __builtin_fmaf(S[t][qt][i], scale2, bias_[i]), mb_, 8 * C_ + 4 * qt + i); } } \
            else { _Pragma("unroll") for (int t = 0; t < 2; ++t) _Pragma("unroll") for (int qt = 0; qt < 2; ++qt) _Pragma("unroll") for (int i = 0; i < 4; ++i) pv[t][qt][i] = S[t][qt][i] * scale2; } \
            if ((KIND_) == 0 && (first_)) { _Pragma("unroll") for (int qt = 0; qt < 2; ++qt) { float mx = -3.0e38f; \
                _Pragma("unroll") for (int t = 0; t < 2; ++t) _Pragma("unroll") for (int i = 0; i < 4; ++i) mx = fmaxf(mx, pv[t][qt][i]); \
                mx = fmaxf(mx, __shfl_xor(mx, 16, 64)); mx = fmaxf(mx, __shfl_xor(mx, 32, 64)); mref[qt] = mx; } } \
            bf16x8_t Pf[2]; \
            _Pragma("unroll") for (int qt = 0; qt < 2; ++qt) { float e[8]; \
                _Pragma("unroll") for (int t = 0; t < 2; ++t) _Pragma("unroll") for (int i = 0; i < 4; ++i) { \
                    if ((KIND_) == 2 && t == 1) e[t * 4 + i] = 0.f; \
                    else { const float ev = __builtin_amdgcn_exp2f(pv[t][qt][i] - mref[qt]); e[t * 4 + i] = ev; lsum[qt] += ev; } } \
                v4u pk; pk.x = cvtpk(e[0], e[1]); pk.y = cvtpk(e[2], e[3]); pk.z = cvtpk(e[4], e[5]); pk.w = cvtpk(e[6], e[7]); \
                Pf[qt] = __builtin_bit_cast(bf16x8_t, pk); } \
            const int t1c_ = (KIND_) == 2 ? (t0_) : (t1_); \
            _Pragma("unroll") for (int dt = 0; dt < 8; ++dt) { \
                const v2u lo_ = *(const v2u*)(vb_ + (t0_) * 4096 + dt * 512), hi_ = *(const v2u*)(vb_ + t1c_ * 4096 + dt * 512); \
                v4u vv; vv.x = lo_.x; vv.y = lo_.y; vv.z = hi_.x; vv.w = hi_.y; \
                const bf16x8_t vf = __builtin_bit_cast(bf16x8_t, vv); \
                O[dt][0] = __builtin_amdgcn_mfma_f32_16x16x32_bf16(vf, Pf[0], O[dt][0], 0, 0, 0); \
                O[dt][1] = __builtin_amdgcn_mfma_f32_16x16x32_bf16(vf, Pf[1], O[dt][1], 0, 0, 0); } \
            __builtin_amdgcn_sched_barrier(0); } while (0)
        NA_FETCH(0, skA0, skA1, svA0, svA1); NA_FETCH(1, skB0, skB1, svB0, svB1);
        NA_PUT(0, skA0, skA1, svA0, svA1);
        __syncthreads();
#define NA_STEP(s_, skx0, skx1, svx0, svx1, sky0, sky1, svy0, svy1) do { const int s = (s_); const int buf = s & 1; \
            NA_FETCH((s + 2 < nsteps ? s + 2 : nsteps - 1), skx0, skx1, svx0, svx1);        \
            __builtin_amdgcn_sched_barrier(0); \
            if (s < 4) { \
                NA_TILES(buf, 0, 1, 0, 0, (s == 0)); \
                NA_TILES(buf, 2, 3, 0, 0, false); \
            } else { \
                const int rho = rho0 + s - 4; \
                if (rho >= r0 && rho < r0 + 8 && s < nsteps) { \
                    const int drow = rho - r + 7; \
                    NA_TILES(buf, ct0, ct0 + 1, 1, drow, false); \
                    NA_TILES(buf, ct0 + 2, ct0 + 2, 2, drow, false); \
                } \
            } \
            NA_PUT(buf ^ 1, sky0, sky1, svy0, svy1); \
            __syncthreads(); } while (0)
#pragma unroll 1
        for (int s2 = 0; s2 < nsteps; s2 += 2) {
            NA_STEP(s2, skA0, skA1, svA0, svA1, skB0, skB1, svB0, svB1);
            NA_STEP(s2 + 1, skB0, skB1, svB0, svB1, skA0, skA1, svA0, svA1);
        }
#undef NA_STEP
#undef NA_FETCH
#undef NA_PUT
#undef NA_TILES
#pragma unroll
        for (int qt = 0; qt < 2; ++qt) {
            float l = lsum[qt];
            l += __shfl_xor(l, 16, 64); l += __shfl_xor(l, 32, 64);
            const float inv = 1.0f / l;
            const int l2 = fresh_tid(w) & 63;
            const unsigned oo = (unsigned)((b * SEQ + r * 64 + q0col + 16 * qt + (l2 & 15)) * D + h * 128 + 4 * (l2 >> 4)) * 2u;
#pragma unroll
            for (int dt = 0; dt < 8; ++dt) {
                v2u o; o.x = pk2(O[dt][qt][0] * inv, O[dt][qt][1] * inv); o.y = pk2(O[dt][qt][2] * inv, O[dt][qt][3] * inv);
                *(v2u*)((char*)p.CAT + oo + 32 * dt) = o;
            }
        }
    }
    __syncthreads();
}

__device__ __forceinline__ int hg_row(int dir, int b, int s) {
    if (dir == 0) return s < CTXL ? TL + b * CTXL + s : b * SEQ + (s - CTXL);
    return s < CTXL ? TL + b * CTXL + (CTXL - 1 - s) : b * SEQ + (SEQ - 1 - (s - CTXL));
}
__device__ __forceinline__ void st_hg_prep(const int tid_, const Args& p) {
    for (int ck = blockIdx.x; ck < T / 16; ck += gridDim.x) {
        const int row0 = ck * 16;
        int b, key0;
        if (row0 < TL) { b = row0 >> 12; key0 = row0 & 4095; } else { b = (row0 - TL) >> 8; key0 = 4096 + ((row0 - TL) & 255); }
        bf16 rq[2][16], rf[2][2][16];
#pragma unroll
        for (int cc = 0; cc < 2; ++cc)
#pragma unroll
            for (int t = 0; t < 16; ++t) {
                const bf16* z = p.Z16 + (size_t)(row0 + t) * 8192 + tid_ + cc * 512;
                rq[cc][t] = z[3 * 1024]; rf[cc][0][t] = z[4 * 1024]; rf[cc][1][t] = z[5 * 1024];
            }
#pragma unroll
        for (int cc = 0; cc < 2; ++cc) {
            const int c = tid_ + cc * 512, h = c >> 7, d = c & 127;
            float q[16];
#pragma unroll
            for (int t = 0; t < 16; ++t) { const float x = bf2f(rq[cc][t]); q[t] = x * __builtin_amdgcn_rcpf(1.0f + __expf(-x)); }
#pragma unroll
            for (int dir = 0; dir < 2; ++dir) {
                const float lb = sigmoidf_(p.hgrn_lb[(dir * 2 + 1) * 1024 + c] - p.hgrn_lb[(dir * 2 + 0) * 1024 + c]);
                float k[16], Pp[16];
                float run = 1.f;
#pragma unroll
                for (int t = 0; t < 16; ++t) {
                    const float x = bf2f(rf[cc][dir][t]);
                    const float sg = __builtin_amdgcn_rcpf(1.0f + __expf(-x));
                    const float f = lb + (1.0f - lb) * sg;
                    k[t] = (1.0f - lb) * (1.0f - sg);
                    run *= f;
                    Pp[t] = run;
                }
                const float etot = run;
                unsigned kh[8];
#pragma unroll
                for (int t = 0; t < 16; ++t) {
                    const float pm1 = t ? Pp[t - 1] : 1.0f;
                    const float eG = dir ? etot * __builtin_amdgcn_rcpf(pm1) : Pp[t];
                    const float enG = __builtin_amdgcn_rcpf(eG);
                    const float eR = etot * enG;
                    const size_t o = ((((size_t)dir * (T / 16) + ck) * 8 + h) * 16 + t) * 128 + d;
                    p.QT[o] = (bf16)f2bf(q[t] * eG);
                    p.KT[o] = (bf16)f2bf(k[t] * enG);
                    const unsigned hb = f2bf(k[t] * eR);
                    if (t & 1) kh[t >> 1] |= hb << 16; else kh[t >> 1] = hb;
                }
                bf16* kd = p.KHT + (((size_t)(dir * 32 + b * 8 + h) * 272 + (key0 >> 4)) * 128 + d) * 16;
                v4u w0, w1; w0.x = kh[0]; w0.y = kh[1]; w0.z = kh[2]; w0.w = kh[3]; w1.x = kh[4]; w1.y = kh[5]; w1.z = kh[6]; w1.w = kh[7];
                *(v4u*)kd = w0; *(v4u*)(kd + 8) = w1;
                p.DEC[((size_t)dir * (T / 16) + ck) * 1024 + c] = etot;
            }
        }
    }
}
struct HgS { v2u a0, a1, b0, b1; f32x4_t d0, d1; };
struct HgO { v2u v0; bf16x8_t qf[4], kf[4]; };
__device__ __forceinline__ void hg_rowkey(int ci, int dir, int b, int& row0, int& key0) {
    const int c = ci < 272 ? ci : 271;
    const int isctx = c < 16 ? 1 : 0;
    const int cc = isctx ? (dir ? 15 - c : c) : (dir ? 255 - (c - 16) : c - 16);
    row0 = (isctx ? TL + b * CTXL : b * SEQ) + 16 * cc;
    key0 = (isctx ? 4096 : 0) + 16 * cc;
}
#define HG_BAR() do { asm volatile("s_waitcnt lgkmcnt(0)" ::: "memory"); __builtin_amdgcn_s_barrier(); asm volatile("" ::: "memory"); } while (0)
#define HG_FRAG(x_) __builtin_bit_cast(bf16x8_t, (v4u){(x_).x, (x_).y, 0u, 0u})
__device__ __forceinline__ void st_hg_seq(const int tid_, const Args& p, float* lds) {
    const int lane = tid_ & 63, w = __builtin_amdgcn_readfirstlane(tid_ >> 6), li = lane & 15, g = lane >> 4;
    bf16* SL = (bf16*)lds;
    for (int u = blockIdx.x; u < 256; u += gridDim.x) {
        const int b = u >> 6, h = (u >> 3) & 7, dir = (u >> 2) & 1, vq = u & 3;
        __syncthreads();
        for (int i = tid_; i < 4 * 32 * 136 / 2; i += NT) ((unsigned*)SL)[i] = 0u;
        __syncthreads();
        if (w < 4) {
            f32x4_t S00 = (f32x4_t){0.f, 0.f, 0.f, 0.f}, S01 = S00, S10 = S00, S11 = S00;
            const bf16* vtb = p.VT6 + ((size_t)(b * 8 + h) * 272 * 128 + vq * 32 + li) * 16 + 4 * g;
            const bf16* khb = p.KHT + ((size_t)(dir * 32 + b * 8 + h) * 272 * 128 + 32 * w + li) * 16 + 4 * g;
            const float* decb = p.DEC + (size_t)dir * (T / 16) * 1024 + h * 128 + 32 * w + 4 * g;
#define S_LOAD(R, ci_) do { int r0_, k0_; hg_rowkey((ci_), dir, b, r0_, k0_); const size_t kc_ = (size_t)(k0_ >> 4) * 2048; \
            R.a0 = *(const v2u*)(vtb + kc_); R.a1 = *(const v2u*)(vtb + kc_ + 256); R.b0 = *(const v2u*)(khb + kc_); R.b1 = *(const v2u*)(khb + kc_ + 256); \
            R.d0 = *(const f32x4_t*)(decb + (size_t)(r0_ >> 4) * 1024); R.d1 = *(const f32x4_t*)(decb + (size_t)(r0_ >> 4) * 1024 + 16); } while (0)
#define S_STEP(R, ci_) do { \
            const bf16x8_t vf0 = HG_FRAG(R.a0), vf1 = HG_FRAG(R.a1), kf0 = HG_FRAG(R.b0), kf1 = HG_FRAG(R.b1); \
            S00 = S00 * R.d0; S01 = S01 * R.d0; S10 = S10 * R.d1; S11 = S11 * R.d1; \
            S00 = __builtin_amdgcn_mfma_f32_16x16x32_bf16(kf0, vf0, S00, 0, 0, 0); S01 = __builtin_amdgcn_mfma_f32_16x16x32_bf16(kf0, vf1, S01, 0, 0, 0); \
            S10 = __builtin_amdgcn_mfma_f32_16x16x32_bf16(kf1, vf0, S10, 0, 0, 0); S11 = __builtin_amdgcn_mfma_f32_16x16x32_bf16(kf1, vf1, S11, 0, 0, 0); \
            bf16* sn = SL + (((ci_) + 1) & 3) * 32 * 136 + li * 136 + 32 * w + 4 * g;        \
            { v2u o_; o_.x = cvtpk(S00[0], S00[1]); o_.y = cvtpk(S00[2], S00[3]); *(v2u*)(sn) = o_; } \
            { v2u o_; o_.x = cvtpk(S01[0], S01[1]); o_.y = cvtpk(S01[2], S01[3]); *(v2u*)(sn + 16 * 136) = o_; } \
            { v2u o_; o_.x = cvtpk(S10[0], S10[1]); o_.y = cvtpk(S10[2], S10[3]); *(v2u*)(sn + 16) = o_; } \
            { v2u o_; o_.x = cvtpk(S11[0], S11[1]); o_.y = cvtpk(S11[2], S11[3]); *(v2u*)(sn + 16 * 136 + 16) = o_; } \
            HG_BAR(); } while (0)
            HgS s0, s1, s2, s3, s4, s5, s6, s7;
            S_LOAD(s0, 0); S_LOAD(s1, 1); S_LOAD(s2, 2); S_LOAD(s3, 3); S_LOAD(s4, 4); S_LOAD(s5, 5); S_LOAD(s6, 6);
            for (int ci = 0; ci < 272; ci += 8) {
                S_LOAD(s7, ci + 7);  S_STEP(s0, ci);
                S_LOAD(s0, ci + 8);  S_STEP(s1, ci + 1);
                S_LOAD(s1, ci + 9);  S_STEP(s2, ci + 2);
                S_LOAD(s2, ci + 10); S_STEP(s3, ci + 3);
                S_LOAD(s3, ci + 11); S_STEP(s4, ci + 4);
                S_LOAD(s4, ci + 12); S_STEP(s5, ci + 5);
                S_LOAD(s5, ci + 13); S_STEP(s6, ci + 6);
                S_LOAD(s6, ci + 14); S_STEP(s7, ci + 7);
            }
            HG_BAR();
#undef S_LOAD
#undef S_STEP
        } else {
            const int ovt = w & 1, sh = (w >> 1) & 1;
            const bf16* vtb = p.VT6 + ((size_t)(b * 8 + h) * 272 * 128 + vq * 32 + ovt * 16 + li) * 16 + 4 * g;
            const bf16* qtb = p.QT + (((size_t)dir * (T / 16) * 8 + h) * 16 + li) * 128 + 8 * g;
            const bf16* ktb = p.KT + (((size_t)dir * (T / 16) * 8 + h) * 16 + li) * 128 + 8 * g;
            bf16* OUT = (bf16*)(dir ? p.OB : p.OF) + h * 128 + vq * 32 + ovt * 16 + 4 * g;
            v2u pfk = {0u, 0u};
#define O_LOAD(R, ci_) do { int r0_, k0_; hg_rowkey((ci_), dir, b, r0_, k0_); R.v0 = *(const v2u*)(vtb + (size_t)(k0_ >> 4) * 2048); const size_t qc_ = (size_t)(r0_ >> 4) * (8 * 16 * 128); \
            _Pragma("unroll") for (int ks = 0; ks < 4; ++ks) { R.qf[ks] = *(const bf16x8_t*)(qtb + qc_ + 32 * ks); R.kf[ks] = *(const bf16x8_t*)(ktb + qc_ + 32 * ks); } } while (0)
#define O_STEP(R, ci_) do { \
            { f32x4_t att0 = (f32x4_t){0.f, 0.f, 0.f, 0.f}, att1 = (f32x4_t){0.f, 0.f, 0.f, 0.f}; \
              att0 = __builtin_amdgcn_mfma_f32_16x16x32_bf16(R.kf[0], R.qf[0], att0, 0, 0, 0); att1 = __builtin_amdgcn_mfma_f32_16x16x32_bf16(R.kf[1], R.qf[1], att1, 0, 0, 0); \
              att0 = __builtin_amdgcn_mfma_f32_16x16x32_bf16(R.kf[2], R.qf[2], att0, 0, 0, 0); att1 = __builtin_amdgcn_mfma_f32_16x16x32_bf16(R.kf[3], R.qf[3], att1, 0, 0, 0); \
              float am[4]; \
              _Pragma("unroll") for (int i = 0; i < 4; ++i) { const int sidx = 4 * g + i; const bool keep = dir ? (sidx >= li) : (sidx <= li); am[i] = keep ? (att0[i] + att1[i]) : 0.f; } \
              pfk.x = cvtpk(am[0], am[1]); pfk.y = cvtpk(am[2], am[3]); } \
            HG_BAR(); \
            { int row0, key0; hg_rowkey((ci_), dir, b, row0, key0); (void)key0; \
              const bf16* so = SL + ((ci_) & 3) * 32 * 136 + (ovt * 16 + li) * 136 + 8 * g; \
              bf16x8_t sf[4]; _Pragma("unroll") for (int ks = 0; ks < 4; ++ks) sf[ks] = *(const bf16x8_t*)(so + 32 * ks); \
              f32x4_t O0 = (f32x4_t){0.f, 0.f, 0.f, 0.f}, O1 = (f32x4_t){0.f, 0.f, 0.f, 0.f}; \
              O0 = __builtin_amdgcn_mfma_f32_16x16x32_bf16(sf[0], R.qf[0], O0, 0, 0, 0); O1 = __builtin_amdgcn_mfma_f32_16x16x32_bf16(sf[1], R.qf[1], O1, 0, 0, 0); \
              O0 = __builtin_amdgcn_mfma_f32_16x16x32_bf16(sf[2], R.qf[2], O0, 0, 0, 0); O1 = __builtin_amdgcn_mfma_f32_16x16x32_bf16(sf[3], R.qf[3], O1, 0, 0, 0); \
              O0 = __builtin_amdgcn_mfma_f32_16x16x32_bf16(HG_FRAG(R.v0), HG_FRAG(pfk), O0, 0, 0, 0); \
              { const f32x4_t s_ = O0 + O1; v2u o_; o_.x = cvtpk(s_[0], s_[1]); o_.y = cvtpk(s_[2], s_[3]); *(v2u*)(OUT + (size_t)(row0 + li) * 1024) = o_; } }       \
            HG_BAR(); } while (0)
            if (sh) HG_BAR();
            HgO o0, o1, o2, o3;
            O_LOAD(o0, sh); O_LOAD(o1, 2 + sh); O_LOAD(o2, 4 + sh);
            for (int m = 0; m < 136; m += 4) {
                const int c = 2 * m + sh;
                O_LOAD(o3, c + 6);  O_STEP(o0, c);
                O_LOAD(o0, c + 8);  O_STEP(o1, c + 2);
                O_LOAD(o1, c + 10); O_STEP(o2, c + 4);
                O_LOAD(o2, c + 12); O_STEP(o3, c + 6);
            }
            if (!sh) HG_BAR();
#undef O_LOAD
#undef O_STEP
        }
    }
    __syncthreads();
}
#undef HG_BAR
#undef HG_FRAG
__device__ __forceinline__ void st_hgrn_out(const int tid_, const Args& p) {
    const int lane = tid_ & 63, gw = blockIdx.x * NWAVES + (tid_ >> 6), nw = gridDim.x * NWAVES;
    for (int row = gw; row < TL; row += nw) {
        float o[16];
        float ss = 0.f;
#pragma unroll
        for (int hh = 0; hh < 2; ++hh) {
            const v4u fw = *(const v4u*)((const bf16*)p.OF + (size_t)row * 1024 + lane * 16 + 8 * hh), bw = *(const v4u*)((const bf16*)p.OB + (size_t)row * 1024 + lane * 16 + 8 * hh);
            const unsigned fa[4] = {fw.x, fw.y, fw.z, fw.w}, ba[4] = {bw.x, bw.y, bw.z, bw.w};
#pragma unroll
            for (int q = 0; q < 4; ++q) {
                o[8 * hh + 2 * q] = __builtin_bit_cast(float, fa[q] << 16) + __builtin_bit_cast(float, ba[q] << 16);
                o[8 * hh + 2 * q + 1] = __builtin_bit_cast(float, fa[q] & 0xffff0000u) + __builtin_bit_cast(float, ba[q] & 0xffff0000u);
            }
        }
#pragma unroll
        for (int i = 0; i < 16; ++i) ss += o[i] * o[i];
        ss += __shfl_xor(ss, 1, 64); ss += __shfl_xor(ss, 2, 64); ss += __shfl_xor(ss, 4, 64);
        const float rs = 1.0f / sqrtf(ss / 128.0f + EPS);
#pragma unroll
        for (int hh = 0; hh < 2; ++hh) {
            const v4u gz = *(const v4u*)(p.Z16 + (size_t)row * 8192 + 7 * 1024 + lane * 16 + 8 * hh);
            const unsigned ga[4] = {gz.x, gz.y, gz.z, gz.w};
            unsigned ow[4];
#pragma unroll
            for (int q = 0; q < 4; ++q) {
                const int c = lane * 16 + 8 * hh + 2 * q;
                const float g0 = __builtin_bit_cast(float, ga[q] << 16), g1 = __builtin_bit_cast(float, ga[q] & 0xffff0000u);
                ow[q] = pk2(o[8 * hh + 2 * q] * rs * p.hgrn_norm_g[c & 127] * siluf_(g0), o[8 * hh + 2 * q + 1] * rs * p.hgrn_norm_g[(c + 1) & 127] * siluf_(g1));
            }
            *(v4u*)(p.CAT + (size_t)row * D + 1024 + lane * 16 + 8 * hh) = (v4u){ow[0], ow[1], ow[2], ow[3]};
        }
    }
}
__device__ __forceinline__ void st_final(const int tid_, const Args& p) {
    const int lane = tid_ & 63, gw = blockIdx.x * NWAVES + (tid_ >> 6), nw = gridDim.x * NWAVES;
    for (int row = gw; row < TL; row += nw) {
        const float4* xr = (const float4*)(p.X + (size_t)row * D);
        float4 v[8];
        float ss = 0.f;
#pragma unroll
        for (int i = 0; i < 8; ++i) { v[i] = xr[lane + 64 * i]; ss += v[i].x * v[i].x + v[i].y * v[i].y + v[i].z * v[i].z + v[i].w * v[i].w; }
        ss = wave_sum(ss);
        const float rs = 1.0f / sqrtf(ss / D + EPS);
#pragma unroll
        for (int i = 0; i < 8; ++i) {
            const float4 gg = ((const float4*)p.final_g)[lane + 64 * i];
            ((float4*)(p.out + (size_t)row * D))[lane + 64 * i] = make_float4(v[i].x * rs * gg.x, v[i].y * rs * gg.y, v[i].z * rs * gg.z, v[i].w * rs * gg.w);
        }
    }
}

__global__ void __launch_bounds__(NT, 2) mega_fwd(Args p) {
    extern __shared__ __attribute__((aligned(16))) unsigned char lds_raw[];
    LAS unsigned char* ldsl = (LAS unsigned char*)lds_raw;
    float* lds = (float*)lds_raw;
    const int wave_id = __builtin_amdgcn_readfirstlane((int)threadIdx.x >> 6);
#define FT() fresh_tid(wave_id)
    volatile LAS unsigned* MISC = (volatile LAS unsigned*)(ldsl + MISC_OFF);
    for (int u = FT(); u < (LDS_BYTES - LDSCTL_OFF) / 4; u += NT) ((LAS unsigned*)(ldsl + LDSCTL_OFF))[u] = 0u;
    __syncthreads();
    XcdBarrier bar; bar.bar = p.ctl + CW_BAR; bar.x = 0; bar.st = nullptr;
    if (!MK_PER_PHASE) bar = xcd_barrier_post(p.ctl + CW_BAR, MISC + 8);
    const int lo = p.ph_lo, hi = p.ph_hi;
    const int Gd = (int)gridDim.x, bx = (int)blockIdx.x;
#ifndef PROBE_DUP
#define PROBE_DUP 0u
#endif
#define PH_BEGIN(k) if (lo <= (k) && (k) < hi) { for (int rep_ = 0; rep_ < (((PROBE_DUP >> (k)) & 1u) ? 2 : 1); ++rep_) {
#define PH_END(k) } if ((k) + 1 < hi) { if (!MK_PER_PHASE) xcd_barrier(bar, FT()); } }

    PH_BEGIN(0) { const int t0_ = FT(); if (bx == 0 && t0_ < 256) ((v4u*)(p.H + (size_t)T * D))[t0_] = (v4u){0u, 0u, 0u, 0u}; } st_weights(FT(), p, lds); st_ada(FT(), p, lds); PH_END(0)
    PH_BEGIN(1) st_router_prep(FT(), p); st_norm_mod(FT(), p, 0, T); PH_END(1)
    PH_BEGIN(2) { pg8::Gemm g{p.H, p.WinT0, T, 4096, D}; pg8::StaticOrder S; S.init(T, 4096, Gd, bx); pg8::EpiBf16 E{p.Z16, 4096, 16};
                  pg8::gemm_phase<pg8::EpiBf16, pg8::StaticOrder, PG8_ALIGN, PG8_SP2>(FT(), ldsl, g, S, E); } PH_END(2)
    PH_BEGIN(3) { const bool sw_ = ((bx >> 3) & 1) != 0;
                  if (sw_) st_l0_pre(FT(), p); st_l0_lru(FT(), p, lds); if (!sw_) st_l0_pre(FT(), p); } PH_END(3)
    PH_BEGIN(4) st_l0_carry(FT(), p); st_l0_conf(FT(), p, lds); PH_END(4)
    PH_BEGIN(5) st_l0_cat(FT(), p); PH_END(5)
    PH_BEGIN(6) { pg8::Gemm g{p.CAT, p.WoutT0, T, D, D}; pg8::StaticOrder S; S.init(T, D, Gd, bx); pg8::EpiResid E{(pg8::bf16_t*)p.X, p.x, p.ctx, p.MOD + 2 * D, 8, TL, D};
                  pg8::gemm_phase<pg8::EpiResid, pg8::StaticOrder, PG8_ALIGN, PG8_SP2>(FT(), ldsl, g, S, E); } PH_END(6)
    PH_BEGIN(7) st_post_mixer(FT(), p, 0, T, lds); PH_END(7)
    PH_BEGIN(8) st_topk(FT(), p, true, lds); st_norm_mod(FT(), p, 0, T, 1, Gd > 64 ? 64 : 0); PH_END(8)
    PH_BEGIN(9) { pg8::Gemm g{p.H, p.WupT, NE * MEP, NE * 4096, D}; pg8::GroupOrder S; S.init(9, 9, 16, NE, Gd, bx); S.list = p.LIST; S.lstride = ME; S.nslots = ME; S.zero_row = T; pg8::EpiSwiGLU E{p.HID, D, 16};
                   pg8::gemm_phase<pg8::EpiSwiGLU, pg8::GroupOrder, PG8_ALIGN, PG8_SP2, true>(FT(), ldsl, g, S, E); } PH_END(9)
    PH_BEGIN(10) { pg8::Gemm g{p.HID, p.WdnT, NE * MEP, NE * D, D}; pg8::GroupOrder S; S.init(9, 9, 8, NE, Gd, bx); S.list = nullptr; S.lstride = 0; S.nslots = 0; S.zero_row = 0; pg8::EpiBf16 E{p.Y16, D, 8};
                   pg8::gemm_phase<pg8::EpiBf16, pg8::GroupOrder, PG8_ALIGN, PG8_SP2>(FT(), ldsl, g, S, E); } PH_END(10)
    PH_BEGIN(11) st_combine<false>(FT(), p, 0, T); st_norm_mod(FT(), p, 1, T); PH_END(11)
    PH_BEGIN(12) { pg8::Gemm g{p.H, p.WinT1, T, 8192, D}; pg8::StaticOrder S; S.init(T, 8192, Gd, bx); pg8::EpiBf16 E{p.Z16, 8192, 32};
                   pg8::gemm_phase<pg8::EpiBf16, pg8::StaticOrder, PG8_ALIGN, PG8_SP2>(FT(), ldsl, g, S, E); } PH_END(12)
    PH_BEGIN(13) { const bool sw_ = ((bx >> 3) & 1) != 0;
                   if (sw_) st_hg_prep(FT(), p); st_vt(FT(), p, lds, 2, p.VT); st_vt(FT(), p, lds, 6, p.VT6); if (!sw_) st_hg_prep(FT(), p); } PH_END(13)
    PH_BEGIN(14) st_hg_seq(FT(), p, lds); st_na(FT(), p, lds); PH_END(14)
    PH_BEGIN(15) st_hgrn_out(FT(), p); PH_END(15)
    PH_BEGIN(16) { pg8::Gemm g{p.CAT, p.WoutT1, TL, D, D}; pg8::StaticOrder S; S.init(TL, D, Gd, bx); pg8::EpiResid E{(pg8::bf16_t*)p.X, nullptr, nullptr, p.MOD + (size_t)5 * 12288 + 2 * D, 8, TL, D};
                   pg8::gemm_phase<pg8::EpiResid, pg8::StaticOrder, PG8_ALIGN, PG8_SP2>(FT(), ldsl, g, S, E); } PH_END(16)
    PH_BEGIN(17) st_post_mixer(FT(), p, 1, TL, lds); PH_END(17)
    PH_BEGIN(18) st_topk(FT(), p, false, lds); st_norm_mod(FT(), p, 1, TL, 1, Gd > 64 ? 64 : 0); PH_END(18)
    PH_BEGIN(19) { pg8::Gemm g{p.H, p.WupT + (size_t)NE * 4096 * D, NE * MEP, NE * 4096, D}; pg8::GroupOrder S; S.init(8, 9, 16, NE, Gd, bx); S.list = p.LIST; S.lstride = ME; S.nslots = 2048; S.zero_row = T; pg8::EpiSwiGLU E{p.HID, D, 16};
                   pg8::gemm_phase<pg8::EpiSwiGLU, pg8::GroupOrder, PG8_ALIGN, PG8_SP2, true>(FT(), ldsl, g, S, E); } PH_END(19)
    PH_BEGIN(20) { pg8::Gemm g{p.HID, p.WdnT + (size_t)NE * D * D, NE * MEP, NE * D, D}; pg8::GroupOrder S; S.init(8, 9, 8, NE, Gd, bx); S.list = nullptr; S.lstride = 0; S.nslots = 0; S.zero_row = 0; pg8::EpiBf16 E{p.Y16, D, 8};
                   pg8::gemm_phase<pg8::EpiBf16, pg8::GroupOrder, PG8_ALIGN, PG8_SP2>(FT(), ldsl, g, S, E); } PH_END(20)
    PH_BEGIN(21) st_combine<true>(FT(), p, 1, TL); PH_END(21)
#undef PH_BEGIN
#undef PH_END
}
}

extern "C" void kernel_launch(void* const* d_in, const int* in_sizes, int n_in, void* d_out, int out_size, void* d_ws, size_t ws_size,
                              hipStream_t stream) {
    static int grid = 0;
    if (grid == 0) {
        int dev = 0, cus = 0;
        if (hipGetDevice(&dev) != hipSuccess || hipDeviceGetAttribute(&cus, hipDeviceAttributeMultiprocessorCount, dev) != hipSuccess) { fprintf(stderr, "kernel_launch: device query failed\n"); grid = -1; return; }
        if (hipFuncSetAttribute((const void*)mega_fwd, hipFuncAttributeMaxDynamicSharedMemorySize, LDS_BYTES) != hipSuccess) { fprintf(stderr, "kernel_launch: hipFuncSetAttribute failed\n"); grid = -1; return; }
        (void)hipGetLastError();
        grid = cus;
    }
    if (grid < 0) return;
    Args p{};
    const float** f = (const float**)&p;
    for (int i = 0; i < 30; ++i) f[i] = (const float*)d_in[i];
    p.out = (float*)d_out;
    char* w = (char*)d_ws;
    size_t off = 0;
    auto take = [&](size_t bytes) { void* r = w + off; off += (bytes + 255) & ~(size_t)255; return r; };
    p.ctl = (unsigned*)take(CTL_BYTES);
    p.WinT0 = (bf16*)take((size_t)4096 * D * 2);
    p.WoutT0 = (bf16*)take((size_t)D * D * 2);
    p.WinT1 = (bf16*)take((size_t)8192 * D * 2);
    p.WoutT1 = (bf16*)take((size_t)D * D * 2);
    p.WupT = (bf16*)take((size_t)2 * NE * 4096 * D * 2);
    p.WdnT = (bf16*)take((size_t)2 * NE * D * D * 2);
    p.X = (float*)take((size_t)T * D * 4);
    p.H = (bf16*)take((size_t)(T + 1) * D * 2);
    p.MOD = (float*)take((size_t)2 * 5 * 12288 * 4);
    p.AFF = (float*)take((size_t)T * NE * 4);
    p.SLOTOF = (int*)take((size_t)T * NE * 4);
    p.LIST = (int*)take((size_t)NE * ME * 4);
    p.GATEV = (float*)take((size_t)NE * ME * 4);
    p.TSP = (float*)take((size_t)(T / 64) * 2 * 1024 * 4);
    p.TSH = (float*)take((size_t)(T / 64) * 2 * 1024 * 4);
    p.CIN = (float*)take((size_t)(T / 64) * 2 * 1024 * 4);
    p.DEC = (float*)take((size_t)2 * (T / 16) * 1024 * 4);
    p.RTH = (bf16*)take((size_t)2 * 5 * NE * D * 2);
    p.RTL = (bf16*)take((size_t)2 * 5 * NE * D * 2);
    p.RBIAS = (float*)take((size_t)2 * 5 * NE * 4);
    const size_t scratch0 = off;
    p.Z = (float*)take((size_t)T * 8192 * 4);
    p.CAT = (bf16*)take((size_t)T * D * 2);
    p.O = (float*)take((size_t)T * D * 4);
    p.AB = (float*)take((size_t)T * G * 4);
    p.BB = (float*)take((size_t)T * G * 4);
    const size_t end_mixer = off;
    p.U = p.Z + (size_t)T * 4096;
    p.XL = p.U + (size_t)T * G;
    p.AF = p.XL + (size_t)T * G;
    p.BF = p.AF + (size_t)T * G;
    p.OF = p.AB; p.OB = p.BB;
    p.Z16 = (bf16*)p.Z;
    p.VT = (bf16*)(p.Z + (size_t)T * 4096);
    p.VT6 = p.VT + (size_t)32 * 128 * 4352;
    p.KHT = p.VT6 + (size_t)32 * 128 * 4352;
    p.QT = p.KHT + (size_t)2 * 32 * 128 * 4352;
    p.KT = p.QT + (size_t)2 * T * 1024;
    off = scratch0;
    p.XS = (bf16*)take((size_t)NE * MEP * D * 2);
    p.HID = (bf16*)take((size_t)NE * MEP * D * 2);
    p.Y16 = (bf16*)take((size_t)NE * MEP * D * 2); p.Y = nullptr;
    const size_t need = off > end_mixer ? off : end_mixer;
    if (need > ws_size) { fprintf(stderr, "kernel_launch: workspace too small: need %zu have %zu\n", need, ws_size); return; }
    (void)in_sizes; (void)n_in; (void)out_size;
    if (hipMemsetAsync(p.ctl, 0, CTL_BYTES, stream) != hipSuccess) { fprintf(stderr, "kernel_launch: memset failed\n"); return; }
#if MK_PER_PHASE
    for (int k = 0; k < NPHASES; ++k) { p.ph_lo = k; p.ph_hi = k + 1; hipLaunchKernelGGL(mega_fwd, dim3(grid), dim3(NT), LDS_BYTES, stream, p); }
#else
    p.ph_lo = 0; p.ph_hi = NPHASES;
    hipLaunchKernelGGL(mega_fwd, dim3(grid), dim3(NT), LDS_BYTES, stream, p);
#endif
    const hipError_t le = hipPeekAtLastError();
    if (le != hipSuccess) fprintf(stderr, "kernel_launch: launch failed: %s\n", hipGetErrorName(le));
}
```

```cpp
#include <hip/hip_runtime.h>
#include <cstdio>
#include <cstdint>
#define LAS __attribute__((address_space(3)))

namespace pg8 {
#define PG8_LAS __attribute__((address_space(3)))
typedef unsigned short bf16_t;
typedef short bf16x8 __attribute__((ext_vector_type(8)));
typedef float f32x4 __attribute__((ext_vector_type(4)));
typedef unsigned u32x4 __attribute__((ext_vector_type(4)));
constexpr int BM = 256, BK = 64, HALF = 128, HTB = HALF * BK * 2  , STAGE_BYTES = 8 * HTB, NXCD = 8, WGM = 8;

__host__ __device__ __forceinline__ int lds_byte(int r, int c) { const int st = (r >> 4) * 2 + (c >> 5), rr = r & 15, cc = c & 31, ob = rr * 64 + cc * 2; return st * 1024 + (ob ^ (((ob >> 9) & 1) << 5)); }
__host__ __device__ __forceinline__ void stage_rc(int b, int& R, int& C) { const int st = b / 1024, sb = b % 1024, swz = sb ^ (((sb >> 9) & 1) << 5); R = (st >> 1) * 16 + swz / 64; C = (st & 1) * 32 + (swz % 64) / 2; }
__host__ __device__ __forceinline__ int perm32(int rho) { const int n = rho >> 4, i = rho & 15; return 8 * (i >> 2) + 4 * n + (i & 3); }

struct Unit { int pm, pn; };
struct Gemm { const bf16_t* A; const bf16_t* Bt; int M, N, K; };

struct StaticOrder {
    int nM, nN, nwg, G, c;
    __host__ __device__ void init(int M, int N, int G_, int c_) { nM = M / BM; nN = N / BM; nwg = nM * nN; G = G_; c = c_; }
    __host__ __device__ bool next(int i, Unit& u) const {
        const long L = (long)i * G + c; if (L >= nwg) return false;
        int wgid = (int)L; { const int q = nwg / NXCD, r = nwg % NXCD, xcd = wgid % NXCD, off = wgid / NXCD; wgid = (xcd < r ? xcd * (q + 1) : r * (q + 1) + (xcd - r) * q) + off; }
        const int nig = WGM * nN, gid = wgid / nig, fm = gid * WGM, gsz = (nM - fm) < WGM ? (nM - fm) : WGM;
        u.pm = fm + ((wgid % nig) % gsz); u.pn = (wgid % nig) / gsz; return true;
    }
    __device__ __forceinline__ void a_ready(const Unit&) const {}
    __device__ __forceinline__ void done(const Unit&) const {}
};


__device__ __forceinline__ unsigned cvt_pk_bf16(float lo, float hi) { unsigned r; asm volatile("v_cvt_pk_bf16_f32 %0, %1, %2" : "=v"(r) : "v"(lo), "v"(hi)); return r; }


struct EpiF32 {
    static constexpr bool PERM = false, AFTER_DRAIN = false;
    float* C; int ldc; int colmod;
    __device__ __forceinline__ void operator()(const f32x4 (&acc)[2][2][4][2], const Unit& u, int wr, int wc, int fr, int fq) const {
        const int row0 = u.pm * BM + wr * 64 + fr, col0 = (u.pn % colmod) * BM + wc * 32 + 4 * fq;
#pragma unroll
        for (int ai = 0; ai < 2; ++ai)
#pragma unroll
            for (int m = 0; m < 4; ++m) { float* rowp = C + (size_t)(row0 + ai * HALF + m * 16) * ldc + col0;
#pragma unroll
                for (int bj = 0; bj < 2; ++bj)
#pragma unroll
                    for (int n = 0; n < 2; ++n) *(f32x4*)(rowp + bj * HALF + n * 16) = acc[ai][bj][m][n]; }
    }
};
struct EpiResid {
    static constexpr bool PERM = true, AFTER_DRAIN = false;
    bf16_t* X; const float* xlat; const float* xctx; const float* mod; int colmod; int TLrows; int ldx;
    __device__ __forceinline__ void operator()(const f32x4 (&acc)[2][2][4][2], const Unit& u, int wr, int wc, int fr, int fq) const {
        const int row0 = u.pm * BM + wr * 64 + fr, col0 = (u.pn % colmod) * BM + wc * 32 + 8 * fq;
        const bool lat = u.pm * BM < TLrows;
        const int mrow = lat ? (u.pm >> 4) : 4;
        const float* md = mod + (size_t)mrow * 12288 + col0;
        const float* sbase = xlat ? (lat ? xlat : xctx - (size_t)TLrows * ldx) : nullptr;
#pragma unroll
        for (int bj = 0; bj < 2; ++bj) {
            const f32x4 g0 = *(const f32x4*)(md + bj * HALF), g1 = *(const f32x4*)(md + bj * HALF + 4);
#pragma unroll
            for (int ai = 0; ai < 2; ++ai)
#pragma unroll
                for (int m = 0; m < 4; ++m) {
                    const size_t o = (size_t)(row0 + ai * HALF + m * 16) * ldx + col0 + bj * HALF;
                    f32x4 s0, s1;
                    if (sbase) { s0 = *(const f32x4*)(sbase + o); s1 = *(const f32x4*)(sbase + o + 4); }
                    else { const u32x4 w = *(const u32x4*)(X + o);
                        s0 = (f32x4){__builtin_bit_cast(float, w.x << 16), __builtin_bit_cast(float, w.x & 0xffff0000u), __builtin_bit_cast(float, w.y << 16), __builtin_bit_cast(float, w.y & 0xffff0000u)};
                        s1 = (f32x4){__builtin_bit_cast(float, w.z << 16), __builtin_bit_cast(float, w.z & 0xffff0000u), __builtin_bit_cast(float, w.w << 16), __builtin_bit_cast(float, w.w & 0xffff0000u)}; }
                    const f32x4 r0 = s0 + g0 * acc[ai][bj][m][0], r1 = s1 + g1 * acc[ai][bj][m][1];
                    u32x4 w; w.x = cvt_pk_bf16(r0[0], r0[1]); w.y = cvt_pk_bf16(r0[2], r0[3]); w.z = cvt_pk_bf16(r1[0], r1[1]); w.w = cvt_pk_bf16(r1[2], r1[3]);
                    *(u32x4*)(X + o) = w;
                }
        }
    }
};
struct EpiBf16 {
    static constexpr bool PERM = true, AFTER_DRAIN = false;
    bf16_t* O; int ldc; int colmod;
    __device__ __forceinline__ void operator()(const f32x4 (&acc)[2][2][4][2], const Unit& u, int wr, int wc, int fr, int fq) const {
        const int row0 = u.pm * BM + wr * 64 + fr, col0 = (u.pn % colmod) * BM + wc * 32 + 8 * fq;
#pragma unroll
        for (int ai = 0; ai < 2; ++ai)
#pragma unroll
            for (int m = 0; m < 4; ++m) { bf16_t* rowp = O + (size_t)(row0 + ai * HALF + m * 16) * ldc + col0;
#pragma unroll
                for (int bj = 0; bj < 2; ++bj) { const f32x4 v0 = acc[ai][bj][m][0], v1 = acc[ai][bj][m][1];
                    u32x4 w; w.x = cvt_pk_bf16(v0[0], v0[1]); w.y = cvt_pk_bf16(v0[2], v0[3]); w.z = cvt_pk_bf16(v1[0], v1[1]); w.w = cvt_pk_bf16(v1[2], v1[3]);
                    *(u32x4*)(rowp + bj * HALF) = w; } }
    }
};
struct EpiSwiGLU {
    static constexpr bool PERM = true, AFTER_DRAIN = false;
    bf16_t* O; int ldc; int colmod;
    __device__ __forceinline__ void operator()(const f32x4 (&acc)[2][2][4][2], const Unit& u, int wr, int wc, int fr, int fq) const {
        const int row0 = u.pm * BM + wr * 64 + fr, col0 = (u.pn % colmod) * HALF + wc * 32 + 8 * fq;
#pragma unroll
        for (int ai = 0; ai < 2; ++ai)
#pragma unroll
            for (int m = 0; m < 4; ++m) { bf16_t* rowp = O + (size_t)(row0 + ai * HALF + m * 16) * ldc + col0;
                float h[8];
#pragma unroll
                for (int n = 0; n < 2; ++n)
#pragma unroll
                    for (int i = 0; i < 4; ++i) { const float g = acc[ai][0][m][n][i], v = acc[ai][1][m][n][i]; h[n * 4 + i] = g * __builtin_amdgcn_rcpf(1.0f + __expf(-g)) * v; }
                u32x4 w; w.x = cvt_pk_bf16(h[0], h[1]); w.y = cvt_pk_bf16(h[2], h[3]); w.z = cvt_pk_bf16(h[4], h[5]); w.w = cvt_pk_bf16(h[6], h[7]);
                *(u32x4*)rowp = w; }
    }
};
struct GroupOrder {
    int nM, nMs, nN, nE, nwg, G, c;
    const int* list; int lstride, nslots, zero_row;
    __device__ __forceinline__ int a_row(const Unit& u, int r) const { const int e = u.pm / nMs, slot = (u.pm - e * nMs) * BM + r; return slot < nslots ? list[e * lstride + slot] : zero_row; }
    __host__ __device__ void init(int nM_, int nMs_, int nN_, int nE_, int G_, int c_) { nM = nM_; nMs = nMs_; nN = nN_; nE = nE_; nwg = nM * nN * nE; G = G_; c = c_; }
    __host__ __device__ bool next(int i, Unit& u) const {
        const long L = (long)i * G + c; if (L >= nwg) return false;
        int wgid = (int)L; { const int q = nwg / NXCD, r = nwg % NXCD, xcd = wgid % NXCD, off = wgid / NXCD; wgid = (xcd < r ? xcd * (q + 1) : r * (q + 1) + (xcd - r) * q) + off; }
        const int per = nM * nN, e = wgid / per, r2 = wgid % per, tn = r2 / nM, tm = r2 % nM;
        u.pm = e * nMs + tm; u.pn = e * nN + tn; return true;
    }
    __device__ __forceinline__ void a_ready(const Unit&) const {}
    __device__ __forceinline__ void done(const Unit&) const {}
};

template <class Epi, class Sched, bool ALIGN_EPI = false, bool SP2 = false, bool GATHER = false>
__device__ __forceinline__ void gemm_phase(const int tid_in, PG8_LAS unsigned char* lds, const Gemm g, const Sched& S, const Epi& E) {
    const int tid = tid_in, wid = __builtin_amdgcn_readfirstlane(tid >> 6), lane = tid & 63, wr = wid >> 2, wc = wid & 3, fr = lane & 15, fq = lane >> 4;
    const int K = g.K, nt = K / BK;
    unsigned voffA[2], voffB[2]; int RA[2], CA[2];
#pragma unroll
    for (int i = 0; i < 2; ++i) { int R, C; stage_rc(tid * 16 + i * 8192, R, C); const int Rb = Epi::PERM ? ((R & ~31) + perm32(R & 31)) : R;
        voffA[i] = (unsigned)(R * K + C) * 2u; voffB[i] = (unsigned)(Rb * K + C) * 2u; RA[i] = R; CA[i] = C; }
    static_assert(!GATHER || SP2, "GATHER is wired into the SP2 loop only");
    unsigned gA[2][2] = {{0u, 0u}, {0u, 0u}}, gN[2][2] = {{0u, 0u}, {0u, 0u}};
#define PG8_GOFF(VO, un) do { _Pragma("unroll") for (int _h = 0; _h < 2; ++_h) _Pragma("unroll") for (int _i = 0; _i < 2; ++_i) \
        VO[_h][_i] = (unsigned)(S.a_row(un, _h * HALF + RA[_i]) * K + CA[_i]) * 2u; } while (0)
#define PG8_STAGE_G(bufoff, kbyte, VOH) do { _Pragma("unroll") for (int _i = 0; _i < 2; ++_i) \
        __builtin_amdgcn_global_load_lds((const unsigned*)((const char*)g.A + (kbyte) + (VOH)[_i]), (PG8_LAS unsigned*)(lds + (bufoff) + ldsw + _i * 8192), 16, 0, 0); } while (0)
    const size_t kstep = (size_t)(BK * 2);
    const size_t hstep = (size_t)HALF * K * 2;
    const size_t tstep = 2 * hstep;
    const unsigned ldsw = (unsigned)wid * 1024u;
    const int aoff = lds_byte(wr * 64 + fr, fq * 8), boff = lds_byte(wc * 32 + fr, fq * 8);
#define PG8_SA(b, h) (((b) * 2 + (h)) * HTB)
#define PG8_SB(b, h) ((4 + (b) * 2 + (h)) * HTB)
#define PG8_STAGE(bufoff, gbase, voff) do { _Pragma("unroll") for (int _i = 0; _i < 2; ++_i) \
        __builtin_amdgcn_global_load_lds((const unsigned*)((const char*)(gbase) + (voff)[_i]), (PG8_LAS unsigned*)(lds + (bufoff) + ldsw + _i * 8192), 16, 0, 0); } while (0)
#define PG8_LDA(dst, b, h) do { _Pragma("unroll") for (int m = 0; m < 4; ++m) _Pragma("unroll") for (int k = 0; k < 2; ++k) dst[m][k] = *(const PG8_LAS bf16x8*)(lds + PG8_SA(b, h) + aoff + m * 2048 + k * 1024); } while (0)
#define PG8_LDB(dst, b, h) do { _Pragma("unroll") for (int n = 0; n < 2; ++n) _Pragma("unroll") for (int k = 0; k < 2; ++k) dst[n][k] = *(const PG8_LAS bf16x8*)(lds + PG8_SB(b, h) + boff + n * 2048 + k * 1024); } while (0)
#define PG8_MMA(ai, bj, At, Bt) do { __builtin_amdgcn_s_setprio(1); _Pragma("unroll") for (int m = 0; m < 4; ++m) _Pragma("unroll") for (int n = 0; n < 2; ++n) _Pragma("unroll") for (int k = 0; k < 2; ++k) \
        acc[ai][bj][m][n] = __builtin_amdgcn_mfma_f32_16x16x32_bf16(Bt[n][k], At[m][k], acc[ai][bj][m][n], 0, 0, 0); __builtin_amdgcn_s_setprio(0); } while (0)
#define PG8_WAIT_V(n) asm volatile("s_waitcnt vmcnt(" #n ")" ::: "memory")
#define PG8_WAIT_L(n) asm volatile("s_waitcnt lgkmcnt(" #n ")" ::: "memory")
#define PG8_BAR __builtin_amdgcn_s_barrier()
#define PG8_SCHED __builtin_amdgcn_sched_barrier(0)
    Unit cur, nxt; int ui = 0;
    if (!S.next(0, cur)) return;
    f32x4 acc[2][2][4][2];
#pragma unroll
    for (int a = 0; a < 2; ++a)
#pragma unroll
        for (int b = 0; b < 2; ++b)
#pragma unroll
            for (int m = 0; m < 4; ++m)
#pragma unroll
                for (int n = 0; n < 2; ++n) acc[a][b][m][n] = (f32x4){0.f, 0.f, 0.f, 0.f};
    bf16x8 At[4][2], B0[2][2], B1[2][2];
    const char* cA = (const char*)g.A + (size_t)cur.pm * tstep; const char* cB = (const char*)g.Bt + (size_t)cur.pn * tstep;
    S.a_ready(cur);
    if constexpr (SP2) {
        if constexpr (GATHER) PG8_GOFF(gA, cur);
        PG8_STAGE(PG8_SB(0, 0), cB, voffB); PG8_STAGE(PG8_SB(0, 1), cB + hstep, voffB);
        if constexpr (GATHER) { PG8_STAGE_G(PG8_SA(0, 0), 0, gA[0]); PG8_STAGE_G(PG8_SA(0, 1), 0, gA[1]); } else { PG8_STAGE(PG8_SA(0, 0), cA, voffA); PG8_STAGE(PG8_SA(0, 1), cA + hstep, voffA); }
        if (wr == 1) PG8_BAR;
        PG8_WAIT_V(2); PG8_BAR;
        PG8_STAGE(PG8_SB(1, 0), cB + kstep, voffB);
        if constexpr (GATHER) PG8_STAGE_G(PG8_SA(1, 0), kstep, gA[0]); else PG8_STAGE(PG8_SA(1, 0), cA + kstep, voffA);
        PG8_STAGE(PG8_SB(1, 1), cB + hstep + kstep, voffB);
        PG8_WAIT_V(6); PG8_BAR;
    } else {
        PG8_STAGE(PG8_SB(0, 0), cB, voffB); PG8_STAGE(PG8_SA(0, 0), cA, voffA); PG8_STAGE(PG8_SB(0, 1), cB + hstep, voffB); PG8_STAGE(PG8_SA(0, 1), cA + hstep, voffA);
        if (wr == 1) PG8_BAR;
        PG8_WAIT_V(4); PG8_BAR;
        PG8_STAGE(PG8_SB(1, 0), cB + kstep, voffB); PG8_STAGE(PG8_SA(1, 0), cA + kstep, voffA); PG8_STAGE(PG8_SB(1, 1), cB + hstep + kstep, voffB);
        PG8_WAIT_V(6); PG8_BAR;
    }
    for (;;) {
        const bool has_next = S.next(ui + 1, nxt);
        const char* nA = has_next ? (const char*)g.A + (size_t)nxt.pm * tstep : cA; const char* nB = has_next ? (const char*)g.Bt + (size_t)nxt.pn * tstep : cB;
        if constexpr (GATHER) { if (has_next) PG8_GOFF(gN, nxt); else { _Pragma("unroll") for (int _h = 0; _h < 2; ++_h) _Pragma("unroll") for (int _i = 0; _i < 2; ++_i) gN[_h][_i] = gA[_h][_i]; } }
        for (int t = 0; t < nt; t += 2) {
            const bool last = (t == nt - 2);
            const char* a1 = cA + (size_t)(t + 1) * kstep;
            const char* a2 = last ? nA : cA + (size_t)(t + 2) * kstep; const char* b2 = last ? nB : cB + (size_t)(t + 2) * kstep;
            const char* a3 = a2 + kstep; const char* b3 = b2 + kstep;
            const size_t k1b = (size_t)(t + 1) * kstep, k2b = last ? 0 : (size_t)(t + 2) * kstep, k3b = k2b + kstep;
            unsigned g2[2][2];
            if constexpr (GATHER) { _Pragma("unroll") for (int _h = 0; _h < 2; ++_h) _Pragma("unroll") for (int _i = 0; _i < 2; ++_i) g2[_h][_i] = last ? gN[_h][_i] : gA[_h][_i]; }
            (void)k1b; (void)k2b; (void)k3b; (void)g2;
            if (last && has_next) S.a_ready(nxt);
            if constexpr (SP2) {
            PG8_LDB(B0, 0, 0); PG8_LDB(B1, 0, 1); PG8_SCHED; PG8_LDA(At, 0, 0); if constexpr (GATHER) PG8_STAGE_G(PG8_SA(1, 1), k1b, gA[1]); else PG8_STAGE(PG8_SA(1, 1), a1 + hstep, voffA);
            PG8_WAIT_V(8); PG8_WAIT_L(0); PG8_BAR; PG8_MMA(0, 0, At, B0); PG8_MMA(0, 1, At, B1); PG8_BAR; PG8_SCHED;
            PG8_LDA(At, 0, 1); PG8_STAGE(PG8_SB(0, 0), b2, voffB); PG8_STAGE(PG8_SB(0, 1), b2 + hstep, voffB); if constexpr (GATHER) PG8_STAGE_G(PG8_SA(0, 0), k2b, g2[0]); else PG8_STAGE(PG8_SA(0, 0), a2, voffA);
            PG8_WAIT_V(8); PG8_WAIT_L(0); PG8_BAR; PG8_MMA(1, 0, At, B0); PG8_MMA(1, 1, At, B1); PG8_BAR; PG8_SCHED;
            PG8_LDB(B0, 1, 0); PG8_LDB(B1, 1, 1); PG8_SCHED; PG8_LDA(At, 1, 0); if constexpr (GATHER) PG8_STAGE_G(PG8_SA(0, 1), k2b, g2[1]); else PG8_STAGE(PG8_SA(0, 1), a2 + hstep, voffA);
            PG8_WAIT_V(8); PG8_WAIT_L(0); PG8_BAR; PG8_MMA(0, 0, At, B0); PG8_MMA(0, 1, At, B1); PG8_BAR; PG8_SCHED;
            PG8_LDA(At, 1, 1); PG8_STAGE(PG8_SB(1, 0), b3, voffB); PG8_STAGE(PG8_SB(1, 1), b3 + hstep, voffB); if constexpr (GATHER) PG8_STAGE_G(PG8_SA(1, 0), k3b, g2[0]); else PG8_STAGE(PG8_SA(1, 0), a3, voffA);
            PG8_WAIT_V(8); PG8_WAIT_L(0); PG8_BAR; PG8_MMA(1, 0, At, B0); PG8_MMA(1, 1, At, B1); PG8_BAR; PG8_SCHED;
            } else {
            PG8_LDB(B0, 0, 0); PG8_SCHED; PG8_LDA(At, 0, 0); PG8_STAGE(PG8_SA(1, 1), a1 + hstep, voffA);
            PG8_WAIT_L(8); PG8_BAR; PG8_WAIT_L(0); PG8_MMA(0, 0, At, B0); PG8_BAR; PG8_SCHED;
            PG8_LDB(B1, 0, 1); PG8_STAGE(PG8_SB(0, 0), b2, voffB);
            PG8_BAR; PG8_WAIT_L(0); PG8_MMA(0, 1, At, B1); PG8_BAR;
            PG8_LDA(At, 0, 1); PG8_STAGE(PG8_SA(0, 0), a2, voffA);
            PG8_BAR; PG8_WAIT_L(0); PG8_MMA(1, 0, At, B0); PG8_BAR; PG8_SCHED;
            PG8_STAGE(PG8_SB(0, 1), b2 + hstep, voffB);
            PG8_WAIT_V(6); PG8_BAR; PG8_MMA(1, 1, At, B1); PG8_BAR;
            PG8_LDB(B0, 1, 0); PG8_SCHED; PG8_LDA(At, 1, 0); PG8_STAGE(PG8_SA(0, 1), a2 + hstep, voffA);
            PG8_WAIT_L(8); PG8_BAR; PG8_WAIT_L(0); PG8_MMA(0, 0, At, B0); PG8_BAR; PG8_SCHED;
            PG8_LDB(B1, 1, 1); PG8_STAGE(PG8_SB(1, 0), b3, voffB);
            PG8_BAR; PG8_WAIT_L(0); PG8_MMA(0, 1, At, B1); PG8_BAR;
            PG8_LDA(At, 1, 1); PG8_STAGE(PG8_SA(1, 0), a3, voffA);
            PG8_BAR; PG8_WAIT_L(0); PG8_MMA(1, 0, At, B0); PG8_BAR; PG8_SCHED;
            PG8_STAGE(PG8_SB(1, 1), b3 + hstep, voffB);
            PG8_WAIT_V(6); PG8_BAR; PG8_MMA(1, 1, At, B1); PG8_BAR;
            }
        }
        if constexpr (ALIGN_EPI) { if (wr == 0) PG8_BAR; }
        if constexpr (!Epi::AFTER_DRAIN) { E(acc, cur, wr, wc, fr, fq); S.done(cur); }
        if (!has_next) break;
#pragma unroll
        for (int a = 0; a < 2; ++a)
#pragma unroll
            for (int b = 0; b < 2; ++b)
#pragma unroll
                for (int m = 0; m < 4; ++m)
#pragma unroll
                    for (int n = 0; n < 2; ++n) acc[a][b][m][n] = (f32x4){0.f, 0.f, 0.f, 0.f};
        cur = nxt; cA = nA; cB = nB; ++ui;
        if constexpr (GATHER) { _Pragma("unroll") for (int _h = 0; _h < 2; ++_h) _Pragma("unroll") for (int _i = 0; _i < 2; ++_i) gA[_h][_i] = gN[_h][_i]; }
        if constexpr (ALIGN_EPI) { if (wr == 1) PG8_BAR; }
    }
    PG8_WAIT_V(0);
    if constexpr (!ALIGN_EPI) { if (wr == 0) PG8_BAR; }
    PG8_BAR;
    if constexpr (Epi::AFTER_DRAIN) { E.fused(acc, cur, wr, wc, fr, fq, lds, wid, lane); S.done(cur); }
#undef PG8_GOFF
#undef PG8_STAGE_G
#undef PG8_SA
#undef PG8_SB
#undef PG8_STAGE
#undef PG8_LDA
#undef PG8_LDB
#undef PG8_MMA
#undef PG8_WAIT_V
#undef PG8_WAIT_L
#undef PG8_BAR
#undef PG8_SCHED
}
}

#define XB_TMO      128
#define XB_XCNT(j)  (256  + 64 * (j))
#define XB_XSUB(j)  (1280 + 64 * (j))
#define XB_XGEN(j)  (2304 + 64 * (j))
#define XB_TOP      3328
#define XB_TOPGEN   3392
#define XCD_BAR_WORDS 3456
#define XB_SPIN_CAP (1u << 18)

__device__ __forceinline__ unsigned xb_ld(unsigned* p)              { return __hip_atomic_load(p, __ATOMIC_RELAXED, __HIP_MEMORY_SCOPE_AGENT); }
__device__ __forceinline__ unsigned xb_add(unsigned* p, unsigned v) { return __hip_atomic_fetch_add(p, v, __ATOMIC_RELAXED, __HIP_MEMORY_SCOPE_AGENT); }
__device__ __forceinline__ unsigned xb_xcc_id() { return (unsigned)__builtin_amdgcn_s_getreg((3 << 11) | 20) & 0xFu; }
#define XB_SPIN(cond, bar) do { unsigned _sp = 0; while (cond) { __builtin_amdgcn_s_sleep(1); \
    if ((++_sp & 255u) == 0u) { if (xb_ld(&(bar)[XB_TMO])) break; if (_sp > XB_SPIN_CAP) { atomicAdd(&(bar)[XB_TMO], 1u); break; } } } } while (0)

struct XcdBarrier {
    unsigned* bar; unsigned x;
    volatile LAS unsigned* st;
};

__device__ __forceinline__ XcdBarrier xcd_barrier_post(unsigned* bar, volatile LAS unsigned* st) {
    XcdBarrier b; b.bar = bar; b.x = xb_xcc_id(); b.st = st;
    if (threadIdx.x == 0) (void)xb_add(&bar[XB_XCNT(b.x)], 1u);
    return b;
}
__device__ __forceinline__ void xcd_barrier_complete(unsigned* bar, unsigned x, unsigned& nloc, unsigned& nx) {
    const unsigned G = gridDim.x * gridDim.y * gridDim.z;
    unsigned sum, cnt, mine, sp = 0u;
    for (;;) {
        sum = 0u; cnt = 0u; mine = 0u;
#pragma unroll
        for (unsigned j = 0; j < 16; ++j) { const unsigned c = xb_ld(&bar[XB_XCNT(j)]); sum += c; cnt += (c > 0u) ? 1u : 0u; mine = (j == x) ? c : mine; }
        if (sum == G) break;
        __builtin_amdgcn_s_sleep(1);
        if ((++sp & 255u) == 0u) { if (xb_ld(&bar[XB_TMO])) break; if (sp > XB_SPIN_CAP) { atomicAdd(&bar[XB_TMO], 1u); break; } }
    }
    nloc = mine > 0u ? mine : 1u; nx = cnt > 0u ? cnt : 1u;
}

__device__ __forceinline__ void xcd_barrier(const XcdBarrier& b, const int tid_) {
    asm volatile("s_waitcnt vmcnt(0)" ::: "memory");
    __syncthreads();
    if (tid_ == 0) {
        unsigned* bar = b.bar;
        __builtin_amdgcn_s_waitcnt(0);
        unsigned nloc = b.st[0], nx = b.st[1];
        if (nloc == 0u) { xcd_barrier_complete(bar, b.x, nloc, nx); b.st[0] = nloc; b.st[1] = nx; }
        const unsigned old = xb_add(&bar[XB_XSUB(b.x)], 1u);
        const unsigned gen = old / nloc;
        if (old + 1u == (gen + 1u) * nloc) {
            __builtin_amdgcn_fence(__ATOMIC_RELEASE, "agent");
            asm volatile("s_waitcnt vmcnt(0)" ::: "memory");
            const unsigned og = xb_add(&bar[XB_TOP], 1u);
            const unsigned tg = og / nx;
            if (og + 1u == (tg + 1u) * nx) xb_add(&bar[XB_TOPGEN], 1u);
            else XB_SPIN(xb_ld(&bar[XB_TOPGEN]) == tg, bar);
            __builtin_amdgcn_fence(__ATOMIC_ACQUIRE, "agent");
            xb_add(&bar[XB_XGEN(b.x)], 1u);
            asm volatile("s_waitcnt vmcnt(0)" ::: "memory");
        } else {
            XB_SPIN(xb_ld(&bar[XB_XGEN(b.x)]) == gen, bar);
            __builtin_amdgcn_fence(__ATOMIC_ACQUIRE, "agent");
            asm volatile("s_waitcnt vmcnt(0)" ::: "memory");
        }
    }
    __syncthreads();
}


namespace {
#define GAS __attribute__((address_space(1)))
typedef unsigned short bf16;
typedef unsigned v4u __attribute__((ext_vector_type(4)));
typedef unsigned v2u __attribute__((ext_vector_type(2)));
typedef short bf16x8_t __attribute__((ext_vector_type(8)));
typedef float f32x4_t __attribute__((ext_vector_type(4)));
typedef float f32x2_t __attribute__((ext_vector_type(2)));

constexpr int D = 2048, NB = 4, SEQ = 4096, CTXL = 256, G = 1024;
constexpr int TL = NB * SEQ, TC = NB * CTXL, T = TL + TC;
constexpr int NE = 16, ME = 2176, MEP = 2304;
constexpr int NT = 512, NWAVES = 8;
constexpr float EPS = 1e-6f;
constexpr int RING_BYTES = 131072, LDSCTL_OFF = RING_BYTES, MISC_OFF = LDSCTL_OFF + 320, LDS_BYTES = 147456;
constexpr size_t CTL_BYTES = 1u << 20;
constexpr int CW_BAR = 4096;
#ifndef MK_PER_PHASE
#define MK_PER_PHASE 0
#endif
constexpr int NPHASES = 22;
#ifndef PG8_SP2
#define PG8_SP2 true
#endif
#ifndef PG8_ALIGN
#define PG8_ALIGN true
#endif

struct Args {
    const float *x, *c, *ctx, *c_ctx, *ada_w, *ada_b, *norm_g, *final_g, *ab_w_in, *ab_w_out,
        *conf_dw_w, *conf_dw_b, *conf_ln_g, *conf_ln_b, *lru_conv_w, *lru_conv_b, *lru_wa, *lru_ba,
        *lru_wi, *lru_bi, *lru_lam, *cd_w_in, *cd_w_out, *na_bias, *hgrn_lb, *hgrn_norm_g,
        *moe_router, *moe_w1, *moe_w3, *moe_w2;
    float* out;
    unsigned* ctl;
    bf16 *WinT0, *WoutT0, *WinT1, *WoutT1, *WupT, *WdnT;
    float *X, *MOD, *AFF, *GATEV;
    int *SLOTOF, *LIST;
    bf16 *H, *CAT, *XS, *HID, *Z16, *VT, *VT6, *Y16, *QT, *KT, *KHT, *RTH, *RTL;
    float *Z, *O, *U, *XL, *AF, *BF, *AB, *BB, *OF, *OB, *Y, *TSP, *TSH, *CIN, *DEC, *RBIAS;
    int ph_lo, ph_hi;
};

__device__ __forceinline__ int fresh_tid(int wid) { int l; asm volatile("v_mbcnt_lo_u32_b32 %0, -1, 0\n\tv_mbcnt_hi_u32_b32 %0, -1, %0" : "=v"(l)); return wid * 64 + l; }
__device__ __forceinline__ float sigmoidf_(float v) { return __builtin_amdgcn_rcpf(1.0f + __expf(-v)); }
__device__ __forceinline__ float siluf_(float v) { return v * __builtin_amdgcn_rcpf(1.0f + __expf(-v)); }
__device__ __forceinline__ float wave_sum(float v) {
#pragma unroll
    for (int o = 32; o >= 1; o >>= 1) v += __shfl_xor(v, o, 64);
    return v;
}
typedef __bf16 bf16x2v_t __attribute__((ext_vector_type(2)));
__device__ __forceinline__ unsigned cvtpk(float lo, float hi) { const f32x2_t v = {lo, hi}; const bf16x2v_t b = __builtin_convertvector(v, bf16x2v_t); return __builtin_bit_cast(unsigned, b); }
__device__ __forceinline__ unsigned f2bf(float f) { return cvtpk(f, 0.f) & 0xffffu; }
__device__ __forceinline__ float bf2f(bf16 v) { return __builtin_bit_cast(float, (unsigned)v << 16); }
__device__ __forceinline__ unsigned pk2(float lo, float hi) { return cvtpk(lo, hi); }
__device__ __forceinline__ float4 ldx4(const bf16* q) { const v2u w = *(const v2u*)q; return make_float4(__builtin_bit_cast(float, w.x << 16), __builtin_bit_cast(float, w.x & 0xffff0000u), __builtin_bit_cast(float, w.y << 16), __builtin_bit_cast(float, w.y & 0xffff0000u)); }
__device__ __forceinline__ void stx4(bf16* q, const float4 v) { v2u o; o.x = pk2(v.x, v.y); o.y = pk2(v.z, v.w); *(v2u*)q = o; }
__device__ __forceinline__ int mod_row(int row) { return row < TL ? (row >> 12) : 4; }
__device__ __forceinline__ void seq_pos(int row, int& n, int& len) {
    if (row < TL) { n = row & (SEQ - 1); len = SEQ; } else { n = (row - TL) & (CTXL - 1); len = CTXL; }
}

__device__ __forceinline__ void transpose_item(const float* W, int K, int N, bf16* WT, int k0, int n0, int drow0, float* scr, int lane) {
#pragma unroll 8
    for (int i = 0; i < 32; ++i) { const int kk = 2 * i + (lane >> 5); scr[kk * 33 + (lane & 31)] = __builtin_nontemporal_load(W + (size_t)(k0 + kk) * N + n0 + (lane & 31)); }
    asm volatile("s_waitcnt lgkmcnt(0)" ::: "memory");
    const int c = lane & 7;
#pragma unroll
    for (int j = 0; j < 4; ++j) { const int n = (lane >> 3) + 8 * j; const float* s = scr + (8 * c) * 33 + n;
        v4u o; o.x = pk2(s[0 * 33], s[1 * 33]); o.y = pk2(s[2 * 33], s[3 * 33]); o.z = pk2(s[4 * 33], s[5 * 33]); o.w = pk2(s[6 * 33], s[7 * 33]);
        __builtin_nontemporal_store(o, (v4u*)(WT + (size_t)(drow0 + n) * K + k0 + 8 * c)); }
    asm volatile("s_waitcnt lgkmcnt(0)" ::: "memory");
}
__device__ __forceinline__ void st_weights(const int tid_, const Args& p, float* lds) {
    const int lane = tid_ & 63, w = tid_ >> 6, gw = blockIdx.x * NWAVES + w, ngw = gridDim.x * NWAVES;
    float* scr = lds + w * 4096;
    constexpr int I_SQ = 32 * 64;
    constexpr int I_MOE = 2 * NE * 3 * I_SQ;
    constexpr int I_IN0 = 32 * 128, I_IN1 = 32 * 256;
    constexpr int NITEMS = I_MOE + I_IN0 + I_SQ + I_IN1 + I_SQ;
    for (int it = gw; it < NITEMS; it += ngw) {
        int r = it;
        if (r < I_MOE) {
            const int mat = r / I_SQ, ii = r % I_SQ, l = mat / 48, e = (mat % 48) / 3, which = mat % 3;
            const int kb = ii / 64, nb = ii % 64, k0 = kb * 64, n0 = nb * 32;
            const size_t wo = ((size_t)l * NE + e) * D * D;
            if (which == 2) transpose_item(p.moe_w2 + wo, D, D, p.WdnT + wo, k0, n0, n0, scr, lane);
            else {
                const int drow0 = 256 * (n0 >> 7) + (n0 & 127) + (which ? 128 : 0);
                transpose_item((which ? p.moe_w3 : p.moe_w1) + wo, D, D, p.WupT + 2 * wo, k0, n0, drow0, scr, lane);
            }
            continue;
        }
        r -= I_MOE;
        if (r < I_IN0) { const int kb = r / 128, nb = r % 128; transpose_item(p.ab_w_in, D, 4096, p.WinT0, kb * 64, nb * 32, nb * 32, scr, lane); continue; }
        r -= I_IN0;
        if (r < I_SQ) { const int kb = r / 64, nb = r % 64; transpose_item(p.ab_w_out, D, D, p.WoutT0, kb * 64, nb * 32, nb * 32, scr, lane); continue; }
        r -= I_SQ;
        if (r < I_IN1) { const int kb = r / 256, nb = r % 256; transpose_item(p.cd_w_in, D, 8192, p.WinT1, kb * 64, nb * 32, nb * 32, scr, lane); continue; }
        r -= I_IN1;
        { const int kb = r / 64, nb = r % 64; transpose_item(p.cd_w_out, D, D, p.WoutT1, kb * 64, nb * 32, nb * 32, scr, lane); }
    }
}
__device__ __forceinline__ void st_init(const int tid_, const Args& p) {
    const size_t n4 = (size_t)T * D / 4, nl4 = (size_t)TL * D / 4;
    for (size_t i = (size_t)blockIdx.x * NT + tid_; i < n4; i += (size_t)gridDim.x * NT) {
        float4 v = i < nl4 ? ((const float4*)p.x)[i] : ((const float4*)p.ctx)[i - nl4];
        ((float4*)p.X)[i] = v;
    }
}
__device__ __forceinline__ void st_ada(const int tid_, const Args& p, float* lds) {
    const int tid = tid_, lane = tid & 63, w = tid >> 6;
    float* sl = lds;
    float* red = lds + 5 * D;
    __syncthreads();
    for (int i = tid; i < 5 * D; i += NT) { const int r = i >> 11, k = i & (D - 1); sl[i] = siluf_(r < 4 ? p.c[r * D + k] : p.c_ctx[k]); }
    __syncthreads();
    for (int u = blockIdx.x; u < 384; u += gridDim.x) {
        const int l = u / 192, j = (u % 192) * 64 + lane;
        const float* W = p.ada_w + (size_t)l * D * 12288 + j;
        float acc[5] = {0.f, 0.f, 0.f, 0.f, 0.f};
#pragma unroll 16
        for (int k = w * 256; k < (w + 1) * 256; ++k) {
            const float wv = __builtin_nontemporal_load(W + (size_t)k * 12288);
#pragma unroll
            for (int r = 0; r < 5; ++r) acc[r] += sl[r * D + k] * wv;
        }
        __syncthreads();
#pragma unroll
        for (int r = 0; r < 5; ++r) red[(w * 5 + r) * 64 + lane] = acc[r];
        __syncthreads();
        if (tid < 320) {
            const int r = tid >> 6;
            float sum = 0.f;
            for (int ww = 0; ww < 8; ++ww) sum += red[(ww * 5 + r) * 64 + lane];
            p.MOD[((size_t)l * 5 + r) * 12288 + j] = sum + p.ada_b[l * 12288 + j];
        }
    }
    __syncthreads();
}

__device__ __forceinline__ void st_norm_mod(const int tid_, const Args& p, int l, int nrows, int which = 0, int b0 = 0) {
    if ((int)blockIdx.x < b0) return;
    const int lane = tid_ & 63, gw = ((int)blockIdx.x - b0) * NWAVES + (tid_ >> 6), nw = ((int)gridDim.x - b0) * NWAVES;
    const float* g = p.norm_g + (size_t)(l * 2 + which) * D;
    const bool fromX = !(l == 0 && which == 0);
    const int rpw = (nrows + nw - 1) / nw, r_lo = gw * rpw, r_hi = (r_lo + rpw < nrows) ? r_lo + rpw : nrows;
    float4 A[8], B[8];
    int cur_m = -1;
    for (int row = r_lo; row < r_hi; ++row) {
        const int m = mod_row(row);
        if (m != cur_m) {
            cur_m = m;
            const float* md = p.MOD + ((size_t)l * 5 + m) * 12288 + (which ? 3 * D : 0);
#pragma unroll
            for (int i = 0; i < 8; ++i) {
                const int j = (lane + 64 * i) * 4;
                const float4 gg = *(const float4*)(g + j), sh = *(const float4*)(md + j), sc = *(const float4*)(md + D + j);
                A[i] = make_float4(gg.x * (1.f + sc.x), gg.y * (1.f + sc.y), gg.z * (1.f + sc.z), gg.w * (1.f + sc.w)); B[i] = sh;
            }
        }
        const float* xr = row < TL ? p.x + (size_t)row * D : p.ctx + (size_t)(row - TL) * D;
        float4 v[8];
        float ss = 0.f;
#pragma unroll
        for (int i = 0; i < 8; ++i) { v[i] = fromX ? ldx4((const bf16*)p.X + (size_t)row * D + (lane + 64 * i) * 4) : ((const float4*)xr)[lane + 64 * i]; ss += v[i].x * v[i].x + v[i].y * v[i].y + v[i].z * v[i].z + v[i].w * v[i].w; }
        ss = wave_sum(ss);
        const float rs = 1.0f / sqrtf(ss / D + EPS);
#pragma unroll
        for (int i = 0; i < 8; ++i) {
            const int j = (lane + 64 * i) * 4;
            v2u o;
            o.x = pk2(v[i].x * rs * A[i].x + B[i].x, v[i].y * rs * A[i].y + B[i].y);
            o.y = pk2(v[i].z * rs * A[i].z + B[i].z, v[i].w * rs * A[i].w + B[i].w);
            *(v2u*)(p.H + (size_t)row * D + j) = o;
        }
    }
}

__device__ __forceinline__ void st_l0_pre(const int tid_, const Args& p) {
    const size_t n = (size_t)T * 128;
#pragma unroll 2
    for (size_t idx = (size_t)blockIdx.x * NT + tid_; idx < n; idx += (size_t)gridDim.x * NT) {
        const size_t row = idx >> 7; const int c8 = (int)(idx & 127) * 8;
        const v4u a = *(const v4u*)(p.Z16 + row * 4096 + c8), gt = *(const v4u*)(p.Z16 + row * 4096 + 1024 + c8);
        const unsigned aw[4] = {a.x, a.y, a.z, a.w}, gw_[4] = {gt.x, gt.y, gt.z, gt.w};
        float o[8];
#pragma unroll
        for (int q = 0; q < 4; ++q) {
            const float a0 = __builtin_bit_cast(float, aw[q] << 16), a1 = __builtin_bit_cast(float, aw[q] & 0xffff0000u);
            const float g0 = __builtin_bit_cast(float, gw_[q] << 16), g1 = __builtin_bit_cast(float, gw_[q] & 0xffff0000u);
            o[2 * q] = a0 * __builtin_amdgcn_rcpf(1.0f + __expf(-g0)); o[2 * q + 1] = a1 * __builtin_amdgcn_rcpf(1.0f + __expf(-g1));
        }
        v4u u; u.x = cvtpk(o[0], o[1]); u.y = cvtpk(o[2], o[3]); u.z = cvtpk(o[4], o[5]); u.w = cvtpk(o[6], o[7]);
        *(v4u*)((bf16*)p.U + row * 1024 + c8) = u;
    }
}
template <int RR, int TT>
__device__ __forceinline__ void conf_row_steps(const Args& p, float (&v)[2][TT], const float (&wk)[2][31], int n0, int len, int row0, int c0) {
    if constexpr (RR < TT + 30) {
        const int m = n0 - 15 + RR;
        const bool inseq = (m >= 0 && m < len);
        const unsigned up = *(const unsigned*)((const bf16*)p.U + (size_t)(inseq ? row0 - 15 + RR : row0) * 1024 + c0);
        float2 uu; uu.x = inseq ? __builtin_bit_cast(float, up << 16) : 0.f; uu.y = inseq ? __builtin_bit_cast(float, up & 0xffff0000u) : 0.f;
#pragma unroll
        for (int k = 0; k < 31; ++k) {
            const int t = RR - k;
            if (t >= 0 && t < TT) { v[0][t] += wk[0][k] * uu.x; v[1][t] += wk[1][k] * uu.y; }
        }
        conf_row_steps<RR + 1, TT>(p, v, wk, n0, len, row0, c0);
    }
}
__device__ __forceinline__ void st_l0_conf(const int tid_, const Args& p, float* lds) {
    constexpr int TT = 16;
    const int tid = tid_, lane = tid & 63, w = tid >> 6, c0 = 2 * tid;
    float* part = lds;
    float* stat = lds + 256;
    float wk[2][31];
#pragma unroll
    for (int k = 0; k < 31; ++k) { const float2 ww = *(const float2*)(p.conf_dw_w + k * 1024 + c0); wk[0][k] = ww.x; wk[1][k] = ww.y; }
    const float2 bias = *(const float2*)(p.conf_dw_b + c0), gg = *(const float2*)(p.conf_ln_g + c0), bb = *(const float2*)(p.conf_ln_b + c0);
    for (int u = blockIdx.x; u < T / TT; u += gridDim.x) {
        const int row0 = u * TT;
        int n0, len; seq_pos(row0, n0, len);
        float v[2][TT];
#pragma unroll
        for (int t = 0; t < TT; ++t) { v[0][t] = bias.x; v[1][t] = bias.y; }
        conf_row_steps<0, TT>(p, v, wk, n0, len, row0, c0);
        float a[2 * TT];
#pragma unroll
        for (int t = 0; t < TT; ++t) { a[t] = v[0][t] + v[1][t]; a[TT + t] = v[0][t] * v[0][t] + v[1][t] * v[1][t]; }
#pragma unroll
        for (int st = 0; st < 5; ++st) {
            const int half = TT >> st;
            const int bit = 32 >> st;
            const bool up = (lane & bit) != 0;
#pragma unroll
            for (int i = 0; i < half; ++i) {
                const float send = up ? a[i] : a[i + half];
                const float keep = up ? a[i + half] : a[i];
                a[i] = keep + __shfl_xor(send, bit, 64);
            }
        }
        a[0] += __shfl_xor(a[0], 1, 64);
        __syncthreads();
        if ((lane & 1) == 0) part[w * 32 + (lane >> 1)] = a[0];
        __syncthreads();
        if (tid < 32) {
            float sum = 0.f;
#pragma unroll
            for (int ww = 0; ww < 8; ++ww) sum += part[ww * 32 + tid];
            stat[tid] = sum;
        }
        __syncthreads();
#pragma unroll
        for (int t = 0; t < TT; ++t) {
            const float mu = stat[t] * (1.0f / 1024.0f);
            const float var = stat[TT + t] * (1.0f / 1024.0f) - mu * mu;
            const float rs = 1.0f / sqrtf(fmaxf(var, 0.f) + EPS);
            const float y0 = (v[0][t] - mu) * rs * gg.x + bb.x, y1 = (v[1][t] - mu) * rs * gg.y + bb.y;
            *(unsigned*)(p.CAT + (size_t)(row0 + t) * D + c0) = pk2(siluf_(y0), siluf_(y1));
        }
    }
    __syncthreads();
}
template <int DIR>
__device__ __forceinline__ void lru_epilogue(const Args& p, const f32x4_t (&pa)[4], const f32x4_t (&pi)[4], const float* xs, float bav, float biv, float spv,
                                             int li, int g, int jt, int h, int rt, int row0) {
    constexpr int dir = DIR;
        const int cj = 16 * jt + li, ch = h * 64 + cj;
        float pl[4][4], hl[4][4], segP[4], segH[4];
#pragma unroll
        for (int tt = 0; tt < 4; ++tt) {
            float av[4], bv[4];
#pragma unroll
            for (int e = 0; e < 4; ++e) {
                const float rr = sigmoidf_(pa[tt][e] + bav), ig = sigmoidf_(pi[tt][e] + biv);
                const float log_a = -8.0f * rr * spv;
                av[e] = __expf(log_a);
                const float x2 = 2.0f * log_a;
                const float em_s = -x2 * (1.0f + x2 * (0.5f + x2 * (0.16666667f + x2 * (0.041666668f + x2 * 0.0083333333f))));
                const float em = x2 > -0.1f ? em_s : 1.0f - __expf(x2);
                bv[e] = __builtin_amdgcn_sqrtf(em) * (ig * xs[(16 * tt + 4 * g + e) * 64 + cj]);
            }
            float P = 1.f, hh = 0.f;
#pragma unroll
            for (int q = 0; q < 4; ++q) { const int e = dir ? 3 - q : q; hh = av[e] * hh + bv[e]; P *= av[e]; hl[tt][e] = hh; pl[tt][e] = P; }
            segP[tt] = P; segH[tt] = hh;
        }
        float cP[4], cH[4];
        {
            float rP = 1.f, rH = 0.f;
#pragma unroll
            for (int q = 0; q < 16; ++q) {
                const int qq = dir ? 15 - q : q, tt = qq >> 2, gg = qq & 3;
                const float Pq = __shfl(segP[tt], li + 16 * gg, 64), Hq = __shfl(segH[tt], li + 16 * gg, 64);
                if (gg == g) { cP[tt] = rP; cH[tt] = rH; }
                rH = Pq * rH + Hq; rP *= Pq;
            }
        }
        unsigned* ABo = (unsigned*)(dir ? p.AB : p.AF);
#pragma unroll
        for (int tt = 0; tt < 4; ++tt)
#pragma unroll
            for (int e = 0; e < 4; ++e) {
                const int tok = 16 * tt + 4 * g + e;
                const size_t o = (size_t)(row0 + tok) * 1024 + ch;
                const float pc = pl[tt][e] * cP[tt], hloc = hl[tt][e] + pl[tt][e] * cH[tt];
                ABo[o] = cvtpk(pc, hloc);
                const bool last = dir ? (tok == 0) : (tok == 63);
                if (last) { p.TSP[((size_t)rt * 2 + dir) * 1024 + ch] = pc; p.TSH[((size_t)rt * 2 + dir) * 1024 + ch] = hloc; }
            }
}
__device__ __forceinline__ void st_l0_lru(const int tid_, const Args& p, float* lds) {
    const int tid = tid_, lane = tid & 63, w = __builtin_amdgcn_readfirstlane(tid >> 6), li = lane & 15, g = lane >> 4, j = tid & 63;
    const int dir = w >> 2, jt = w & 3;
    float* xs = lds;
    bf16* xsb = (bf16*)(lds + 4096);
    bf16* WT = (bf16*)(lds + 4096 + 2304);
    bf16* raw = (bf16*)(lds + 4096 + 2304 + 9216);
    const int nunits = (T / 64) * 16;
    int cur_h = -1;
    v4u raw0 = {0u, 0u, 0u, 0u}, raw1 = {0u, 0u, 0u, 0u}; bool have_raw = false;
    float cwv[4] = {0.f, 0.f, 0.f, 0.f}, cbv = 0.f, bav = 0.f, biv = 0.f, spv = 0.f;
    bf16x8_t wf[2][2];
    wf[0][0] = wf[0][1] = wf[1][0] = wf[1][1] = (bf16x8_t){0, 0, 0, 0, 0, 0, 0, 0};
#define LRU_FETCH(uu) do { const int h_ = (uu) & 15, row0_ = ((uu) >> 4) * 64; int n0_, len_; seq_pos(row0_, n0_, len_); \
        { const int r_ = tid >> 3, m_ = n0_ + r_ - 2; raw0 = (v4u){0u, 0u, 0u, 0u}; if (m_ >= 0 && m_ < len_) raw0 = *(const v4u*)(p.Z16 + (size_t)(row0_ + r_ - 2) * 4096 + 3072 + h_ * 64 + (tid & 7) * 8); } \
        if (tid < 24) { const int r_ = 64 + (tid >> 3), m_ = n0_ + r_ - 2; raw1 = (v4u){0u, 0u, 0u, 0u}; if (m_ >= 0 && m_ < len_) raw1 = *(const v4u*)(p.Z16 + (size_t)(row0_ + r_ - 2) * 4096 + 3072 + h_ * 64 + (tid & 7) * 8); } } while (0)
    for (int u = blockIdx.x; u < nunits; u += gridDim.x) {
        const int h = u & 15, rt = u >> 4, row0 = rt * 64;
        __syncthreads();
        if (h != cur_h) {
            for (int i = tid; i < 16384; i += NT) {
                const int s = i >> 12, o = i & 4095, d_ = s >> 1, ii = o >> 6, jj = o & 63;
                const float* src = (s & 1) ? p.lru_wi : p.lru_wa;
                WT[(s * 64 + jj) * 72 + ii] = (bf16)f2bf(src[(size_t)d_ * 16 * 4096 + h * 4096 + o]);
            }
            cur_h = h;
            const int chh = h * 64 + j;
#pragma unroll
            for (int k = 0; k < 4; ++k) cwv[k] = p.lru_conv_w[k * 1024 + chh];
            cbv = p.lru_conv_b[chh];
            const int che = h * 64 + 16 * jt + li;
            bav = p.lru_ba[dir * 1024 + che]; biv = p.lru_bi[dir * 1024 + che]; spv = log1pf(expf(-p.lru_lam[dir * 1024 + che]));
            __syncthreads();
#pragma unroll
            for (int s2 = 0; s2 < 2; ++s2)
#pragma unroll
                for (int ks = 0; ks < 2; ++ks) wf[s2][ks] = *(const bf16x8_t*)(WT + ((2 * dir + s2) * 64 + 16 * jt + li) * 72 + 32 * ks + 8 * g);
        }
        if (!have_raw) { LRU_FETCH(u); }
        {
            v4u* rt16 = (v4u*)raw;
            rt16[tid] = raw0; if (tid < 24) rt16[512 + tid] = raw1;
        }
        __syncthreads();
        { const int un = u + (int)gridDim.x; have_raw = un < nunits; if (have_raw) { LRU_FETCH(un); } }
        for (int i = tid; i < 4096; i += NT) {
            const int r = i >> 6, c = i & 63;
            float acc = cbv;
#pragma unroll
            for (int k = 0; k < 4; ++k) acc += cwv[k] * bf2f(raw[(r + k) * 64 + c]);
            xs[i] = acc;
            xsb[r * 72 + c] = (bf16)f2bf(acc);
        }
        __syncthreads();
        f32x4_t pa[4], pi[4];
#pragma unroll
        for (int tt = 0; tt < 4; ++tt) { pa[tt] = (f32x4_t){0.f, 0.f, 0.f, 0.f}; pi[tt] = (f32x4_t){0.f, 0.f, 0.f, 0.f}; }
#pragma unroll
        for (int tt = 0; tt < 4; ++tt)
#pragma unroll
            for (int ks = 0; ks < 2; ++ks) {
                const bf16x8_t xf = *(const bf16x8_t*)(xsb + (16 * tt + li) * 72 + 32 * ks + 8 * g);
                pa[tt] = __builtin_amdgcn_mfma_f32_16x16x32_bf16(xf, wf[0][ks], pa[tt], 0, 0, 0);
                pi[tt] = __builtin_amdgcn_mfma_f32_16x16x32_bf16(xf, wf[1][ks], pi[tt], 0, 0, 0);
            }
        if (dir) lru_epilogue<1>(p, pa, pi, xs, bav, biv, spv, li, g, jt, h, rt, row0); else lru_epilogue<0>(p, pa, pi, xs, bav, biv, spv, li, g, jt, h, rt, row0);
    }
    __syncthreads();
}
#undef LRU_FETCH
__device__ __forceinline__ void st_l0_carry(const int tid_, const Args& p) {
    const int tid = tid_;
    if (tid < 32) {
        for (int idx = blockIdx.x * 32 + tid; idx < 8192; idx += gridDim.x * 32) {
            const int ch = idx & 1023, b = (idx >> 10) & 3, dir = idx >> 12;
            float c = 0.f;
#pragma unroll 4
            for (int k = 0; k < 68; ++k) {
                int rt;
                if (dir == 0) rt = k < 4 ? (TL / 64 + b * 4 + k) : (b * 64 + (k - 4));
                else rt = k < 4 ? (TL / 64 + b * 4 + 3 - k) : (b * 64 + 63 - (k - 4));
                const size_t o = ((size_t)rt * 2 + dir) * 1024 + ch;
                p.CIN[o] = c;
                c = p.TSP[o] * c + p.TSH[o];
            }
        }
    }
}
__device__ __forceinline__ float gelu_tanh(float v) {
    const float u = 0.7978845608028654f * (v + 0.044715f * v * v * v);
    return v * __builtin_amdgcn_rcpf(1.0f + __expf(-2.0f * u));
}
__device__ __forceinline__ void st_l0_cat(const int tid_, const Args& p) {
    const size_t n = (size_t)T * 256;
#pragma unroll 2
    for (size_t idx = (size_t)blockIdx.x * NT + tid_; idx < n; idx += (size_t)gridDim.x * NT) {
        const size_t row = idx >> 8; const int c4 = (int)(idx & 255) * 4; const size_t rt = row >> 6;
        const v2u zy = *(const v2u*)(p.Z16 + row * 4096 + 2048 + c4);
        const float4 cf = *(const float4*)(p.CIN + (rt * 2 + 0) * 1024 + c4), cb = *(const float4*)(p.CIN + (rt * 2 + 1) * 1024 + c4);
        const size_t o = row * 1024 + c4;
        const v4u pf = *(const v4u*)((const unsigned*)p.AF + o), pb = *(const v4u*)((const unsigned*)p.AB + o);
        float4 af, bf, ab, bb;
        af.x = __builtin_bit_cast(float, pf.x << 16); bf.x = __builtin_bit_cast(float, pf.x & 0xffff0000u); af.y = __builtin_bit_cast(float, pf.y << 16); bf.y = __builtin_bit_cast(float, pf.y & 0xffff0000u);
        af.z = __builtin_bit_cast(float, pf.z << 16); bf.z = __builtin_bit_cast(float, pf.z & 0xffff0000u); af.w = __builtin_bit_cast(float, pf.w << 16); bf.w = __builtin_bit_cast(float, pf.w & 0xffff0000u);
        ab.x = __builtin_bit_cast(float, pb.x << 16); bb.x = __builtin_bit_cast(float, pb.x & 0xffff0000u); ab.y = __builtin_bit_cast(float, pb.y << 16); bb.y = __builtin_bit_cast(float, pb.y & 0xffff0000u);
        ab.z = __builtin_bit_cast(float, pb.z << 16); bb.z = __builtin_bit_cast(float, pb.z & 0xffff0000u); ab.w = __builtin_bit_cast(float, pb.w << 16); bb.w = __builtin_bit_cast(float, pb.w & 0xffff0000u);
        const float z0 = __builtin_bit_cast(float, zy.x << 16), z1 = __builtin_bit_cast(float, zy.x & 0xffff0000u), z2 = __builtin_bit_cast(float, zy.y << 16), z3 = __builtin_bit_cast(float, zy.y & 0xffff0000u);
        v2u r;
        r.x = pk2(gelu_tanh(z0) * (bf.x + af.x * cf.x + bb.x + ab.x * cb.x), gelu_tanh(z1) * (bf.y + af.y * cf.y + bb.y + ab.y * cb.y));
        r.y = pk2(gelu_tanh(z2) * (bf.z + af.z * cf.z + bb.z + ab.z * cb.z), gelu_tanh(z3) * (bf.w + af.w * cf.w + bb.w + ab.w * cb.w));
        *(v2u*)(p.CAT + row * D + 1024 + c4) = r;
    }
}

__device__ __forceinline__ void st_router_prep(const int tid_, const Args& p) {
    const int gt = blockIdx.x * NT + tid_, ngt = gridDim.x * NT;
    for (int i = gt; i < 2 * 5 * D; i += ngt) {
        const int j = i & (D - 1), m = (i >> 11) % 5, l = i / (5 * D);
        const float* md = p.MOD + ((size_t)l * 5 + m) * 12288;
        const float f = p.norm_g[(size_t)(l * 2 + 1) * D + j] * (1.0f + md[4 * D + j]);
        const float* r = p.moe_router + ((size_t)l * D + j) * NE;
#pragma unroll
        for (int e = 0; e < NE; ++e) {
            const float v = f * r[e];
            const unsigned hi = f2bf(v);
            const unsigned lo = f2bf(v - __builtin_bit_cast(float, hi << 16));
            const size_t o = (((size_t)l * 5 + m) * NE + e) * D + j;
            p.RTH[o] = (bf16)hi; p.RTL[o] = (bf16)lo;
        }
    }
    const int lane = tid_ & 63, gw = blockIdx.x * NWAVES + (tid_ >> 6), nw = gridDim.x * NWAVES;
    for (int u = gw; u < 2 * 5 * NE; u += nw) {
        const int e = u & 15, m = (u >> 4) % 5, l = u / 80;
        const float* md = p.MOD + ((size_t)l * 5 + m) * 12288 + 3 * D;
        float acc = 0.f;
        for (int j = lane; j < D; j += 64) acc += md[j] * p.moe_router[((size_t)l * D + j) * NE + e];
        acc = wave_sum(acc);
        if (lane == 0) p.RBIAS[u] = acc;
    }
}
__device__ __forceinline__ void st_post_mixer(const int tid_, const Args& p, int l, int nrows, float* lds) {
    (void)lds;
    const int lane = tid_ & 63, li = lane & 15, g = lane >> 4, gw = blockIdx.x * NWAVES + (tid_ >> 6), nw = gridDim.x * NWAVES;
    const float* gn = p.norm_g + (size_t)(l * 2 + 1) * D;
    for (int tile = gw; tile < nrows / 16; tile += nw) {
        const int row0 = tile * 16, m = mod_row(row0);
        const bf16* xr = (const bf16*)p.X + (size_t)(row0 + li) * D + 8 * g;
        const bf16* rh = p.RTH + (((size_t)l * 5 + m) * NE + li) * D + 8 * g;
        const bf16* rl = p.RTL + (((size_t)l * 5 + m) * NE + li) * D + 8 * g;
        f32x4_t acc0 = (f32x4_t){0.f, 0.f, 0.f, 0.f}, acc1 = acc0;
        float ss = 0.f;
#pragma unroll 8
        for (int ks = 0; ks < 64; ++ks) {
            const v4u xw = *(const v4u*)(xr + 32 * ks);
            const bf16x8_t bh = *(const bf16x8_t*)(rh + 32 * ks), bl = *(const bf16x8_t*)(rl + 32 * ks);
            const unsigned xq[4] = {xw.x, xw.y, xw.z, xw.w};
#pragma unroll
            for (int q = 0; q < 4; ++q) { const float x0 = __builtin_bit_cast(float, xq[q] << 16), x1 = __builtin_bit_cast(float, xq[q] & 0xffff0000u); ss += x0 * x0 + x1 * x1; }
            const bf16x8_t ah = __builtin_bit_cast(bf16x8_t, xw);
            acc0 = __builtin_amdgcn_mfma_f32_16x16x32_bf16(ah, bh, acc0, 0, 0, 0);
            acc1 = __builtin_amdgcn_mfma_f32_16x16x32_bf16(ah, bl, acc1, 0, 0, 0);
        }
        ss += __shfl_xor(ss, 16, 64); ss += __shfl_xor(ss, 32, 64);
        const float rs = 1.0f / sqrtf(ss / D + EPS);
        const float bias = p.RBIAS[(l * 5 + m) * NE + li];
        float lg[4];
#pragma unroll
        for (int i = 0; i < 4; ++i) lg[i] = (acc0[i] + acc1[i]) * __shfl(rs, 4 * g + i, 64) + bias;
#pragma unroll
        for (int i = 0; i < 4; ++i) {
            float mx = lg[i];
#pragma unroll
            for (int o = 8; o >= 1; o >>= 1) mx = fmaxf(mx, __shfl_xor(mx, o, 64));
            const float ev = expf(lg[i] - mx);
            float sum = ev;
#pragma unroll
            for (int o = 8; o >= 1; o >>= 1) sum += __shfl_xor(sum, o, 64);
            const size_t o = (size_t)(row0 + 4 * g + i) * NE + li;
            p.AFF[o] = ev / sum; p.SLOTOF[o] = -1;
        }
    }
}

template <int N, int CAP>
__device__ __forceinline__ void topk_sort_set(const int tid, const Args& p, unsigned long long* keys, int e, int row_base, int slot_base) {
    __syncthreads();
    for (int i = tid; i < N; i += NT) keys[i] = ((unsigned long long)__float_as_uint(p.AFF[(size_t)(row_base + i) * NE + e]) << 32) | (unsigned)(N - 1 - i);
    __syncthreads();
    for (int k = 2; k <= N; k <<= 1) {
        for (int j = k >> 1; j > 0; j >>= 1) {
            for (int t = tid; t < N / 2; t += NT) {
                const int i = ((t & ~(j - 1)) << 1) | (t & (j - 1)), l = i | j;
                const unsigned long long x = keys[i], y = keys[l];
                const bool desc = (i & k) == 0;
                if ((x < y) == desc) { keys[i] = y; keys[l] = x; }
            }
            __syncthreads();
        }
    }
    for (int i = tid; i < CAP; i += NT) {
        const unsigned long long key = keys[i];
        const int row = row_base + (N - 1 - (int)(unsigned)(key & 0xffffffffu)), slot = slot_base + i;
        p.LIST[e * ME + slot] = row; p.GATEV[e * ME + slot] = __uint_as_float((unsigned)(key >> 32)); p.SLOTOF[(size_t)row * NE + e] = slot;
    }
}
__device__ __forceinline__ void st_topk(const int tid_, const Args& p, bool with_ctx, float* lds) {
    unsigned long long* keys = (unsigned long long*)lds;
    const int nunits = with_ctx ? 128 : 64;
    for (int u = blockIdx.x; u < nunits; u += gridDim.x) {
        const int e = u & 15, b = (u >> 4) & 3;
        if (u < 64) topk_sort_set<SEQ, 512>(tid_, p, keys, e, b * SEQ, b * 512);
        else topk_sort_set<CTXL, 32>(tid_, p, keys, e, TL + b * CTXL, 2048 + b * 32);
    }
    __syncthreads();
}

__device__ __forceinline__ void st_gather(const int tid_, const Args& p, int nslots, int npad) {
    const int lane = tid_ & 63, gw = blockIdx.x * NWAVES + (tid_ >> 6), nw = gridDim.x * NWAVES;
    for (int u4 = gw; u4 < NE * npad / 4; u4 += nw) {
        const int u = u4 * 4, e = u / npad, slot0 = u % npad;
        int rows[4];
#pragma unroll
        for (int k = 0; k < 4; ++k) rows[k] = (slot0 + k < nslots) ? p.LIST[e * ME + slot0 + k] : -1;
        v4u v[4][4];
#pragma unroll
        for (int k = 0; k < 4; ++k) {
            const v4u* src = (const v4u*)(p.H + (size_t)(rows[k] < 0 ? 0 : rows[k]) * D);
#pragma unroll
            for (int i = 0; i < 4; ++i) v[k][i] = src[lane + 64 * i];
        }
#pragma unroll
        for (int k = 0; k < 4; ++k) {
            v4u* dst = (v4u*)(p.XS + ((size_t)e * MEP + slot0 + k) * D);
            const v4u z = {0u, 0u, 0u, 0u};
#pragma unroll
            for (int i = 0; i < 4; ++i) dst[lane + 64 * i] = rows[k] < 0 ? z : v[k][i];
        }
    }
}

template <bool FINAL>
__device__ __forceinline__ void st_combine(const int tid_, const Args& p, int l, int nrows) {
    const int lane = tid_ & 63, gw = blockIdx.x * NWAVES + (tid_ >> 6), nw = gridDim.x * NWAVES;
    const int rpw = (nrows + nw - 1) / nw, r_lo = gw * rpw, r_hi = (r_lo + rpw < nrows) ? r_lo + rpw : nrows;
    int slot_n = -1; float gate_n = 0.f;
    if (r_lo < r_hi && lane < NE) { slot_n = p.SLOTOF[(size_t)r_lo * NE + lane]; if (slot_n >= 0) gate_n = p.GATEV[lane * ME + slot_n]; }
    for (int row = r_lo; row < r_hi; ++row) {
        const int slot_v = slot_n; const float gate_v = gate_n;
        slot_n = -1; gate_n = 0.f;
        if (row + 1 < r_hi && lane < NE) { slot_n = p.SLOTOF[(size_t)(row + 1) * NE + lane]; if (slot_n >= 0) gate_n = p.GATEV[lane * ME + slot_n]; }
        const float* md = p.MOD + ((size_t)l * 5 + mod_row(row)) * 12288 + 5 * D;
        float4 acc[8];
#pragma unroll
        for (int i = 0; i < 8; ++i) acc[i] = make_float4(0.f, 0.f, 0.f, 0.f);
        unsigned long long mask = __ballot(slot_v >= 0);
        while (mask) {
            const int e = __builtin_ctzll(mask); mask &= mask - 1;
            const int slot = __builtin_amdgcn_readlane(slot_v, e);
            const float gt = __builtin_bit_cast(float, __builtin_amdgcn_readlane(__builtin_bit_cast(int, gate_v), e));
            const v2u* y = (const v2u*)(p.Y16 + ((size_t)e * MEP + slot) * D);
#pragma unroll
            for (int i = 0; i < 8; ++i) { const v2u yv = y[lane + 64 * i];
                acc[i].x += gt * __builtin_bit_cast(float, yv.x << 16); acc[i].y += gt * __builtin_bit_cast(float, yv.x & 0xffff0000u);
                acc[i].z += gt * __builtin_bit_cast(float, yv.y << 16); acc[i].w += gt * __builtin_bit_cast(float, yv.y & 0xffff0000u); }
        }
        bf16* xr = (bf16*)p.X + (size_t)row * D;
        float ss = 0.f;
#pragma unroll
        for (int i = 0; i < 8; ++i) {
            const float4 m = ((const float4*)md)[lane + 64 * i];
            float4 xv = ldx4(xr + (lane + 64 * i) * 4);
            xv.x += m.x * acc[i].x; xv.y += m.y * acc[i].y; xv.z += m.z * acc[i].z; xv.w += m.w * acc[i].w;
            if (FINAL) { acc[i] = xv; ss += xv.x * xv.x + xv.y * xv.y + xv.z * xv.z + xv.w * xv.w; }
            else stx4(xr + (lane + 64 * i) * 4, xv);
        }
        if (FINAL) {
            ss = wave_sum(ss);
            const float rs = 1.0f / sqrtf(ss / D + EPS);
#pragma unroll
            for (int i = 0; i < 8; ++i) {
                const float4 gg = ((const float4*)p.final_g)[lane + 64 * i];
                ((float4*)(p.out + (size_t)row * D))[lane + 64 * i] = make_float4(acc[i].x * rs * gg.x, acc[i].y * rs * gg.y, acc[i].z * rs * gg.z, acc[i].w * rs * gg.w);
            }
        }
    }
}

__device__ __forceinline__ void st_vt(const int tid_, const Args& p, float* lds, const int colgrp, bf16* dstT) {
    bf16* tile = (bf16*)lds;
    const int tid = tid_;
    for (int u = blockIdx.x; u < (T / 64) * 8; u += gridDim.x) {
        const int h = u & 7, rt = u >> 3, row0 = rt * 64;
        int b, key0;
        if (row0 < TL) { b = row0 >> 12; key0 = row0 & 4095; } else { b = (row0 - TL) >> 8; key0 = 4096 + ((row0 - TL) & 255); }
        __syncthreads();
        for (int i = tid; i < 1024; i += NT) {
            const int tok = i >> 4, c = i & 15;
            const v4u v = *(const v4u*)(p.Z16 + (size_t)(row0 + tok) * 8192 + colgrp * 1024 + h * 128 + c * 8);
            const unsigned wv[4] = {v.x, v.y, v.z, v.w};
#pragma unroll
            for (int q = 0; q < 4; ++q) { tile[(c * 8 + 2 * q) * 72 + tok] = (bf16)(wv[q] & 0xffffu); tile[(c * 8 + 2 * q + 1) * 72 + tok] = (bf16)(wv[q] >> 16); }
        }
        __syncthreads();
        for (int i = tid; i < 1024; i += NT) {
            const int d = i >> 3, c = i & 7;
            const v4u v = *(const v4u*)(tile + d * 72 + c * 8);
            *(v4u*)(dstT + (((size_t)(b * 8 + h) * 272 + (key0 >> 4) + (c >> 1)) * 128 + d) * 16 + (c & 1) * 8) = v;
        }
    }
    __syncthreads();
}
__device__ __forceinline__ float na_sel(int negbits, float x, int mbits, int bit) { const int m = (mbits << (31 - bit)) >> 31; return __builtin_bit_cast(float, (__builtin_bit_cast(int, x) & m) | (negbits & ~m)); }
__device__ __forceinline__ void st_na(const int tid_, const Args& p, float* lds) {
    const int tid = tid_, lane = tid & 63, w = __builtin_amdgcn_readfirstlane(tid >> 6), li = lane & 15, g = lane >> 4;
    const float scale2 = 0.08838834764831845f * 1.4426950408889634f;
    const int negbits = __builtin_bit_cast(int, -1.0e30f);
    const int half = w & 1, rq = w >> 1, q0col = half * 32, ct0 = half;
    int mbits = 0;
#pragma unroll
    for (int C = 0; C < 3; ++C)
#pragma unroll
        for (int qt = 0; qt < 2; ++qt) {
            const int qcol = q0col + 16 * qt + li; int c0q = qcol - 8; c0q = c0q < 0 ? 0 : (c0q > 48 ? 48 : c0q);
#pragma unroll
            for (int i = 0; i < 4; ++i) { const int kcol = 16 * (ct0 + C) + 4 * g + i; mbits |= ((kcol >= c0q) && (kcol < c0q + 16)) ? (1 << (8 * C + 4 * qt + i)) : 0; }
        }
    const bf16* Zb = p.Z16;
    const unsigned tlane = (unsigned)(4 * g - li + 18) * 16u;
    bf16* KL = (bf16*)((char*)lds + 24576);
    bf16* VL = KL + 2 * 64 * 136;
    const unsigned stlane = (unsigned)((tid >> 3) * 8192 + (tid & 7) * 8) * 2u;
    const unsigned kfrag = (unsigned)(li * 136 + 8 * g) * 2u, vfrag = (unsigned)(li * 16 + 4 * g) * 2u;
    for (int U = blockIdx.x; U < 512; U += gridDim.x) {
        const int b = U >> 7, h = (U >> 4) & 7, R = (U & 15) * 4;
        const int r = R + rq;
        int r0 = r - 4; r0 = r0 < 0 ? 0 : (r0 > 56 ? 56 : r0);
        int rho0 = R - 4; rho0 = rho0 < 0 ? 0 : (rho0 > 56 ? 56 : rho0);
        int rho1 = R - 1; rho1 = (rho1 < 0 ? 0 : (rho1 > 56 ? 56 : rho1)) + 7;
        const int nsteps = 4 + (rho1 - rho0 + 1);
        __syncthreads();
        for (int i = fresh_tid(w); i < 15 * 92; i += NT) {
            const int dr = i / 92, k = i - dr * 92 - 29;
            f32x4_t e;
#pragma unroll
            for (int ii = 0; ii < 4; ++ii) { const int d = k - 3 + ii; const int dcl = d < 0 ? 0 : (d > 30 ? 30 : d); const float v = p.na_bias[(h * 15 + dr) * 31 + dcl] * 1.4426950408889634f; e[ii] = (d >= 0 && d <= 30) ? v : 0.f; }
            *(f32x4_t*)(lds + i * 4) = e;
        }
        bf16x8_t Qf[2][4];
#pragma unroll
        for (int qt = 0; qt < 2; ++qt) {
            const unsigned qo = (unsigned)((b * SEQ + r * 64 + q0col + 16 * qt + li) * 8192 + h * 128 + 8 * g) * 2u;
#pragma unroll
            for (int ds = 0; ds < 4; ++ds) Qf[qt][ds] = *(const bf16x8_t*)((const char*)Zb + qo + 64 * ds);
        }
        f32x4_t O[8][2];
#pragma unroll
        for (int dt = 0; dt < 8; ++dt) { O[dt][0] = (f32x4_t){0.f, 0.f, 0.f, 0.f}; O[dt][1] = (f32x4_t){0.f, 0.f, 0.f, 0.f}; }
        float lsum[2] = {0.f, 0.f}, mref[2] = {0.f, 0.f};
        const bf16* VTg = p.VT + (size_t)(b * 8 + h) * 272 * 2048;
        const char* tabu = (const char*)lds + (29 - 16 * half) * 16 - 256;
        v4u skA0, skA1, svA0, svA1, skB0, skB1, svB0, svB1;
#define NA_FETCH(s_, sk0, sk1, sv0, sv1) do { const int s__ = (s_); int krow_, kt_; \
            if (s__ < 4) { krow_ = TL + b * CTXL + 64 * s__; kt_ = 256 + 4 * s__; } else { const int rho_ = rho0 + s__ - 4; krow_ = b * SEQ + rho_ * 64; kt_ = rho_ * 4; } \
            unsigned so_ = stlane; asm volatile("" : "+v"(so_));        \
            const char* ks_ = (const char*)Zb + ((size_t)krow_ * 8192 + 1024 + h * 128) * 2; \
            sk0 = *(const v4u*)(ks_ + so_); sk1 = *(const v4u*)(ks_ + so_ + 128); \
            unsigned vo_ = (unsigned)tid * 16u; asm volatile("" : "+v"(vo_)); \
            const char* vs_ = (const char*)VTg + (size_t)kt_ * 4096; sv0 = *(const v4u*)(vs_ + vo_); sv1 = *(const v4u*)(vs_ + vo_ + 8192); } while (0)
#define NA_PUT(buf_, sk0, sk1, sv0, sv1) do { bf16* kd_ = KL + (buf_) * 64 * 136 + (tid >> 3) * 136 + (tid & 7) * 8; *(v4u*)kd_ = sk0; *(v4u*)(kd_ + 64) = sk1; \
            v4u* vd_ = (v4u*)(VL + (buf_) * 8192); vd_[tid] = sv0; vd_[tid + 512] = sv1; } while (0)
#define NA_TILES(buf_, t0_, t1_, KIND_, drow_, first_) do { \
            const char* kb_ = (const char*)KL + (buf_) * (64 * 136 * 2) + kfrag; const char* vb_ = (const char*)VL + (buf_) * 16384 + vfrag; \
            f32x4_t S[2][2]; \
            _Pragma("unroll") for (int t = 0; t < 2; ++t) { S[t][0] = (f32x4_t){0.f, 0.f, 0.f, 0.f}; S[t][1] = (f32x4_t){0.f, 0.f, 0.f, 0.f}; } \
            _Pragma("unroll") for (int t = 0; t < ((KIND_) == 2 ? 1 : 2); ++t) { const int tl_ = t ? (t1_) : (t0_); \
                _Pragma("unroll") for (int ds = 0; ds < 4; ++ds) { const bf16x8_t kf = *(const bf16x8_t*)(kb_ + tl_ * (16 * 136 * 2) + 64 * ds); \
                    S[t][0] = __builtin_amdgcn_mfma_f32_16x16x32_bf16(kf, Qf[0][ds], S[t][0], 0, 0, 0); \
                    S[t][1] = __builtin_amdgcn_mfma_f32_16x16x32_bf16(kf, Qf[1][ds], S[t][1], 0, 0, 0); } } \
            float pv[2][2][4]; \
            if ((KIND_) != 0) { const char* tb_ = tabu + (drow_) * 1472 + tlane; int mb_ = mbits; asm volatile("" : "+v"(mb_));     \
                _Pragma("unroll") for (int t = 0; t < ((KIND_) == 2 ? 1 : 2); ++t) _Pragma("unroll") for (int qt = 0; qt < 2; ++qt) { const int C_ = (KIND_) == 2 ? 2 : t; \
                    const f32x4_t bias_ = *(const f32x4_t*)(tb_ + (C_ - qt + 1) * 256); \
                    _Pragma("unroll") for (int i = 0; i < 4; ++i) pv[t][qt][i] = na_sel(negbits, __builtin_fmaf(S[t][qt][i], scale2, bias_[i]), mb_, 8 * C_ + 4 * qt + i); } } \
            else { _Pragma("unroll") for (int t = 0; t < 2; ++t) _Pragma("unroll") for (int qt = 0; qt < 2; ++qt) _Pragma("unroll") for (int i = 0; i < 4; ++i) pv[t][qt][i] = S[t][qt][i] * scale2; } \
            if ((KIND_) == 0 && (first_)) { _Pragma("unroll") for (int qt = 0; qt < 2; ++qt) { float mx = -3.0e38f; \
                _Pragma("unroll") for (int t = 0; t < 2; ++t) _Pragma("unroll") for (int i = 0; i < 4; ++i) mx = fmaxf(mx, pv[t][qt][i]); \
                mx = fmaxf(mx, __shfl_xor(mx, 16, 64)); mx = fmaxf(mx, __shfl_xor(mx, 32, 64)); mref[qt] = mx; } } \
            bf16x8_t Pf[2]; \
            _Pragma("unroll") for (int qt = 0; qt < 2; ++qt) { float e[8]; \
                _Pragma("unroll") for (int t = 0; t < 2; ++t) _Pragma("unroll") for (int i = 0; i < 4; ++i) { \
                    if ((KIND_) == 2 && t == 1) e[t * 4 + i] = 0.f; \
                    else { const float ev = __builtin_amdgcn_exp2f(pv[t][qt][i] - mref[qt]); e[t * 4 + i] = ev; lsum[qt] += ev; } } \
                v4u pk; pk.x = cvtpk(e[0], e[1]); pk.y = cvtpk(e[2], e[3]); pk.z = cvtpk(e[4], e[5]); pk.w = cvtpk(e[6], e[7]); \
                Pf[qt] = __builtin_bit_cast(bf16x8_t, pk); } \
            const int t1c_ = (KIND_) == 2 ? (t0_) : (t1_); \
            _Pragma("unroll") for (int dt = 0; dt < 8; ++dt) { \
                const v2u lo_ = *(const v2u*)(vb_ + (t0_) * 4096 + dt * 512), hi_ = *(const v2u*)(vb_ + t1c_ * 4096 + dt * 512); \
                v4u vv; vv.x = lo_.x; vv.y = lo_.y; vv.z = hi_.x; vv.w = hi_.y; \
                const bf16x8_t vf = __builtin_bit_cast(bf16x8_t, vv); \
                O[dt][0] = __builtin_amdgcn_mfma_f32_16x16x32_bf16(vf, Pf[0], O[dt][0], 0, 0, 0); \
                O[dt][1] = __builtin_amdgcn_mfma_f32_16x16x32_bf16(vf, Pf[1], O[dt][1], 0, 0, 0); } \
            __builtin_amdgcn_sched_barrier(0); } while (0)
        NA_FETCH(0, skA0, skA1, svA0, svA1); NA_FETCH(1, skB0, skB1, svB0, svB1);
        NA_PUT(0, skA0, skA1, svA0, svA1);
        __syncthreads();
#define NA_STEP(s_, skx0, skx1, svx0, svx1, sky0, sky1, svy0, svy1) do { const int s = (s_); const int buf = s & 1; \
            NA_FETCH((s + 2 < nsteps ? s + 2 : nsteps - 1), skx0, skx1, svx0, svx1);        \
            __builtin_amdgcn_sched_barrier(0); \
            if (s < 4) { \
                NA_TILES(buf, 0, 1, 0, 0, (s == 0)); \
                NA_TILES(buf, 2, 3, 0, 0, false); \
            } else { \
                const int rho = rho0 + s - 4; \
                if (rho >= r0 && rho < r0 + 8 && s < nsteps) { \
                    const int drow = rho - r + 7; \
                    NA_TILES(buf, ct0, ct0 + 1, 1, drow, false); \
                    NA_TILES(buf, ct0 + 2, ct0 + 2, 2, drow, false); \
                } \
            } \
            NA_PUT(buf ^ 1, sky0, sky1, svy0, svy1); \
            __syncthreads(); } while (0)
#pragma unroll 1
        for (int s2 = 0; s2 < nsteps; s2 += 2) {
            NA_STEP(s2, skA0, skA1, svA0, svA1, skB0, skB1, svB0, svB1);
            NA_STEP(s2 + 1, skB0, skB1, svB0, svB1, skA0, skA1, svA0, svA1);
        }
#undef NA_STEP
#undef NA_FETCH
#undef NA_PUT
#undef NA_TILES
#pragma unroll
        for (int qt = 0; qt < 2; ++qt) {
            float l = lsum[qt];
            l += __shfl_xor(l, 16, 64); l += __shfl_xor(l, 32, 64);
            const float inv = 1.0f / l;
            const int l2 = fresh_tid(w) & 63;
            const unsigned oo = (unsigned)((b * SEQ + r * 64 + q0col + 16 * qt + (l2 & 15)) * D + h * 128 + 4 * (l2 >> 4)) * 2u;
#pragma unroll
            for (int dt = 0; dt < 8; ++dt) {
                v2u o; o.x = pk2(O[dt][qt][0] * inv, O[dt][qt][1] * inv); o.y = pk2(O[dt][qt][2] * inv, O[dt][qt][3] * inv);
                *(v2u*)((char*)p.CAT + oo + 32 * dt) = o;
            }
        }
    }
    __syncthreads();
}

__device__ __forceinline__ int hg_row(int dir, int b, int s) {
    if (dir == 0) return s < CTXL ? TL + b * CTXL + s : b * SEQ + (s - CTXL);
    return s < CTXL ? TL + b * CTXL + (CTXL - 1 - s) : b * SEQ + (SEQ - 1 - (s - CTXL));
}
__device__ __forceinline__ void st_hg_prep(const int tid_, const Args& p) {
    for (int ck = blockIdx.x; ck < T / 16; ck += gridDim.x) {
        const int row0 = ck * 16;
        int b, key0;
        if (row0 < TL) { b = row0 >> 12; key0 = row0 & 4095; } else { b = (row0 - TL) >> 8; key0 = 4096 + ((row0 - TL) & 255); }
        bf16 rq[2][16], rf[2][2][16];
#pragma unroll
        for (int cc = 0; cc < 2; ++cc)
#pragma unroll
            for (int t = 0; t < 16; ++t) {
                const bf16* z = p.Z16 + (size_t)(row0 + t) * 8192 + tid_ + cc * 512;
                rq[cc][t] = z[3 * 1024]; rf[cc][0][t] = z[4 * 1024]; rf[cc][1][t] = z[5 * 1024];
            }
#pragma unroll
        for (int cc = 0; cc < 2; ++cc) {
            const int c = tid_ + cc * 512, h = c >> 7, d = c & 127;
            float q[16];
#pragma unroll
            for (int t = 0; t < 16; ++t) { const float x = bf2f(rq[cc][t]); q[t] = x * __builtin_amdgcn_rcpf(1.0f + __expf(-x)); }
#pragma unroll
            for (int dir = 0; dir < 2; ++dir) {
                const float lb = sigmoidf_(p.hgrn_lb[(dir * 2 + 1) * 1024 + c] - p.hgrn_lb[(dir * 2 + 0) * 1024 + c]);
                float k[16], Pp[16];
                float run = 1.f;
#pragma unroll
                for (int t = 0; t < 16; ++t) {
                    const float x = bf2f(rf[cc][dir][t]);
                    const float sg = __builtin_amdgcn_rcpf(1.0f + __expf(-x));
                    const float f = lb + (1.0f - lb) * sg;
                    k[t] = (1.0f - lb) * (1.0f - sg);
                    run *= f;
                    Pp[t] = run;
                }
                const float etot = run;
                unsigned kh[8];
#pragma unroll
                for (int t = 0; t < 16; ++t) {
                    const float pm1 = t ? Pp[t - 1] : 1.0f;
                    const float eG = dir ? etot * __builtin_amdgcn_rcpf(pm1) : Pp[t];
                    const float enG = __builtin_amdgcn_rcpf(eG);
                    const float eR = etot * enG;
                    const size_t o = ((((size_t)dir * (T / 16) + ck) * 8 + h) * 16 + t) * 128 + d;
                    p.QT[o] = (bf16)f2bf(q[t] * eG);
                    p.KT[o] = (bf16)f2bf(k[t] * enG);
                    const unsigned hb = f2bf(k[t] * eR);
                    if (t & 1) kh[t >> 1] |= hb << 16; else kh[t >> 1] = hb;
                }
                bf16* kd = p.KHT + (((size_t)(dir * 32 + b * 8 + h) * 272 + (key0 >> 4)) * 128 + d) * 16;
                v4u w0, w1; w0.x = kh[0]; w0.y = kh[1]; w0.z = kh[2]; w0.w = kh[3]; w1.x = kh[4]; w1.y = kh[5]; w1.z = kh[6]; w1.w = kh[7];
                *(v4u*)kd = w0; *(v4u*)(kd + 8) = w1;
                p.DEC[((size_t)dir * (T / 16) + ck) * 1024 + c] = etot;
            }
        }
    }
}
struct HgS { v2u a0, a1, b0, b1; f32x4_t d0, d1; };
struct HgO { v2u v0; bf16x8_t qf[4], kf[4]; };
__device__ __forceinline__ void hg_rowkey(int ci, int dir, int b, int& row0, int& key0) {
    const int c = ci < 272 ? ci : 271;
    const int isctx = c < 16 ? 1 : 0;
    const int cc = isctx ? (dir ? 15 - c : c) : (dir ? 255 - (c - 16) : c - 16);
    row0 = (isctx ? TL + b * CTXL : b * SEQ) + 16 * cc;
    key0 = (isctx ? 4096 : 0) + 16 * cc;
}
#define HG_BAR() do { asm volatile("s_waitcnt lgkmcnt(0)" ::: "memory"); __builtin_amdgcn_s_barrier(); asm volatile("" ::: "memory"); } while (0)
#define HG_FRAG(x_) __builtin_bit_cast(bf16x8_t, (v4u){(x_).x, (x_).y, 0u, 0u})
__device__ __forceinline__ void st_hg_seq(const int tid_, const Args& p, float* lds) {
    const int lane = tid_ & 63, w = __builtin_amdgcn_readfirstlane(tid_ >> 6), li = lane & 15, g = lane >> 4;
    bf16* SL = (bf16*)lds;
    for (int u = blockIdx.x; u < 256; u += gridDim.x) {
        const int b = u >> 6, h = (u >> 3) & 7, dir = (u >> 2) & 1, vq = u & 3;
        __syncthreads();
        for (int i = tid_; i < 4 * 32 * 136 / 2; i += NT) ((unsigned*)SL)[i] = 0u;
        __syncthreads();
        if (w < 4) {
            f32x4_t S00 = (f32x4_t){0.f, 0.f, 0.f, 0.f}, S01 = S00, S10 = S00, S11 = S00;
            const bf16* vtb = p.VT6 + ((size_t)(b * 8 + h) * 272 * 128 + vq * 32 + li) * 16 + 4 * g;
            const bf16* khb = p.KHT + ((size_t)(dir * 32 + b * 8 + h) * 272 * 128 + 32 * w + li) * 16 + 4 * g;
            const float* decb = p.DEC + (size_t)dir * (T / 16) * 1024 + h * 128 + 32 * w + 4 * g;
#define S_LOAD(R, ci_) do { int r0_, k0_; hg_rowkey((ci_), dir, b, r0_, k0_); const size_t kc_ = (size_t)(k0_ >> 4) * 2048; \
            R.a0 = *(const v2u*)(vtb + kc_); R.a1 = *(const v2u*)(vtb + kc_ + 256); R.b0 = *(const v2u*)(khb + kc_); R.b1 = *(const v2u*)(khb + kc_ + 256); \
            R.d0 = *(const f32x4_t*)(decb + (size_t)(r0_ >> 4) * 1024); R.d1 = *(const f32x4_t*)(decb + (size_t)(r0_ >> 4) * 1024 + 16); } while (0)
#define S_STEP(R, ci_) do { \
            const bf16x8_t vf0 = HG_FRAG(R.a0), vf1 = HG_FRAG(R.a1), kf0 = HG_FRAG(R.b0), kf1 = HG_FRAG(R.b1); \
            S00 = S00 * R.d0; S01 = S01 * R.d0; S10 = S10 * R.d1; S11 = S11 * R.d1; \
            S00 = __builtin_amdgcn_mfma_f32_16x16x32_bf16(kf0, vf0, S00, 0, 0, 0); S01 = __builtin_amdgcn_mfma_f32_16x16x32_bf16(kf0, vf1, S01, 0, 0, 0); \
            S10 = __builtin_amdgcn_mfma_f32_16x16x32_bf16(kf1, vf0, S10, 0, 0, 0); S11 = __builtin_amdgcn_mfma_f32_16x16x32_bf16(kf1, vf1, S11, 0, 0, 0); \
            bf16* sn = SL + (((ci_) + 1) & 3) * 32 * 136 + li * 136 + 32 * w + 4 * g;        \
            { v2u o_; o_.x = cvtpk(S00[0], S00[1]); o_.y = cvtpk(S00[2], S00[3]); *(v2u*)(sn) = o_; } \
            { v2u o_; o_.x = cvtpk(S01[0], S01[1]); o_.y = cvtpk(S01[2], S01[3]); *(v2u*)(sn + 16 * 136) = o_; } \
            { v2u o_; o_.x = cvtpk(S10[0], S10[1]); o_.y = cvtpk(S10[2], S10[3]); *(v2u*)(sn + 16) = o_; } \
            { v2u o_; o_.x = cvtpk(S11[0], S11[1]); o_.y = cvtpk(S11[2], S11[3]); *(v2u*)(sn + 16 * 136 + 16) = o_; } \
            HG_BAR(); } while (0)
            HgS s0, s1, s2, s3, s4, s5, s6, s7;
            S_LOAD(s0, 0); S_LOAD(s1, 1); S_LOAD(s2, 2); S_LOAD(s3, 3); S_LOAD(s4, 4); S_LOAD(s5, 5); S_LOAD(s6, 6);
            for (int ci = 0; ci < 272; ci += 8) {
                S_LOAD(s7, ci + 7);  S_STEP(s0, ci);
                S_LOAD(s0, ci + 8);  S_STEP(s1, ci + 1);
                S_LOAD(s1, ci + 9);  S_STEP(s2, ci + 2);
                S_LOAD(s2, ci + 10); S_STEP(s3, ci + 3);
                S_LOAD(s3, ci + 11); S_STEP(s4, ci + 4);
                S_LOAD(s4, ci + 12); S_STEP(s5, ci + 5);
                S_LOAD(s5, ci + 13); S_STEP(s6, ci + 6);
                S_LOAD(s6, ci + 14); S_STEP(s7, ci + 7);
            }
            HG_BAR();
#undef S_LOAD
#undef S_STEP
        } else {
            const int ovt = w & 1, sh = (w >> 1) & 1;
            const bf16* vtb = p.VT6 + ((size_t)(b * 8 + h) * 272 * 128 + vq * 32 + ovt * 16 + li) * 16 + 4 * g;
            const bf16* qtb = p.QT + (((size_t)dir * (T / 16) * 8 + h) * 16 + li) * 128 + 8 * g;
            const bf16* ktb = p.KT + (((size_t)dir * (T / 16) * 8 + h) * 16 + li) * 128 + 8 * g;
            bf16* OUT = (bf16*)(dir ? p.OB : p.OF) + h * 128 + vq * 32 + ovt * 16 + 4 * g;
            v2u pfk = {0u, 0u};
#define O_LOAD(R, ci_) do { int r0_, k0_; hg_rowkey((ci_), dir, b, r0_, k0_); R.v0 = *(const v2u*)(vtb + (size_t)(k0_ >> 4) * 2048); const size_t qc_ = (size_t)(r0_ >> 4) * (8 * 16 * 128); \
            _Pragma("unroll") for (int ks = 0; ks < 4; ++ks) { R.qf[ks] = *(const bf16x8_t*)(qtb + qc_ + 32 * ks); R.kf[ks] = *(const bf16x8_t*)(ktb + qc_ + 32 * ks); } } while (0)
#define O_STEP(R, ci_) do { \
            { f32x4_t att0 = (f32x4_t){0.f, 0.f, 0.f, 0.f}, att1 = (f32x4_t){0.f, 0.f, 0.f, 0.f}; \
              att0 = __builtin_amdgcn_mfma_f32_16x16x32_bf16(R.kf[0], R.qf[0], att0, 0, 0, 0); att1 = __builtin_amdgcn_mfma_f32_16x16x32_bf16(R.kf[1], R.qf[1], att1, 0, 0, 0); \
              att0 = __builtin_amdgcn_mfma_f32_16x16x32_bf16(R.kf[2], R.qf[2], att0, 0, 0, 0); att1 = __builtin_amdgcn_mfma_f32_16x16x32_bf16(R.kf[3], R.qf[3], att1, 0, 0, 0); \
              float am[4]; \
              _Pragma("unroll") for (int i = 0; i < 4; ++i) { const int sidx = 4 * g + i; const bool keep = dir ? (sidx >= li) : (sidx <= li); am[i] = keep ? (att0[i] + att1[i]) : 0.f; } \
              pfk.x = cvtpk(am[0], am[1]); pfk.y = cvtpk(am[2], am[3]); } \
            HG_BAR(); \
            { int row0, key0; hg_rowkey((ci_), dir, b, row0, key0); (void)key0; \
              const bf16* so = SL + ((ci_) & 3) * 32 * 136 + (ovt * 16 + li) * 136 + 8 * g; \
              bf16x8_t sf[4]; _Pragma("unroll") for (int ks = 0; ks < 4; ++ks) sf[ks] = *(const bf16x8_t*)(so + 32 * ks); \
              f32x4_t O0 = (f32x4_t){0.f, 0.f, 0.f, 0.f}, O1 = (f32x4_t){0.f, 0.f, 0.f, 0.f}; \
              O0 = __builtin_amdgcn_mfma_f32_16x16x32_bf16(sf[0], R.qf[0], O0, 0, 0, 0); O1 = __builtin_amdgcn_mfma_f32_16x16x32_bf16(sf[1], R.qf[1], O1, 0, 0, 0); \
              O0 = __builtin_amdgcn_mfma_f32_16x16x32_bf16(sf[2], R.qf[2], O0, 0, 0, 0); O1 = __builtin_amdgcn_mfma_f32_16x16x32_bf16(sf[3], R.qf[3], O1, 0, 0, 0); \
              O0 = __builtin_amdgcn_mfma_f32_16x16x32_bf16(HG_FRAG(R.v0), HG_FRAG(pfk), O0, 0, 0, 0); \
              { const f32x4_t s_ = O0 + O1; v2u o_; o_.x = cvtpk(s_[0], s_[1]); o_.y = cvtpk(s_[2], s_[3]); *(v2u*)(OUT + (size_t)(row0 + li) * 1024) = o_; } }       \
            HG_BAR(); } while (0)
            if (sh) HG_BAR();
            HgO o0, o1, o2, o3;
            O_LOAD(o0, sh); O_LOAD(o1, 2 + sh); O_LOAD(o2, 4 + sh);
            for (int m = 0; m < 136; m += 4) {
                const int c = 2 * m + sh;
                O_LOAD(o3, c + 6);  O_STEP(o0, c);
                O_LOAD(o0, c + 8);  O_STEP(o1, c + 2);
                O_LOAD(o1, c + 10); O_STEP(o2, c + 4);
                O_LOAD(o2, c + 12); O_STEP(o3, c + 6);
            }
            if (!sh) HG_BAR();
#undef O_LOAD
#undef O_STEP
        }
    }
    __syncthreads();
}
#undef HG_BAR
#undef HG_FRAG
__device__ __forceinline__ void st_hgrn_out(const int tid_, const Args& p) {
    const int lane = tid_ & 63, gw = blockIdx.x * NWAVES + (tid_ >> 6), nw = gridDim.x * NWAVES;
    for (int row = gw; row < TL; row += nw) {
        float o[16];
        float ss = 0.f;
#pragma unroll
        for (int hh = 0; hh < 2; ++hh) {
            const v4u fw = *(const v4u*)((const bf16*)p.OF + (size_t)row * 1024 + lane * 16 + 8 * hh), bw = *(const v4u*)((const bf16*)p.OB + (size_t)row * 1024 + lane * 16 + 8 * hh);
            const unsigned fa[4] = {fw.x, fw.y, fw.z, fw.w}, ba[4] = {bw.x, bw.y, bw.z, bw.w};
#pragma unroll
            for (int q = 0; q < 4; ++q) {
                o[8 * hh + 2 * q] = __builtin_bit_cast(float, fa[q] << 16) + __builtin_bit_cast(float, ba[q] << 16);
                o[8 * hh + 2 * q + 1] = __builtin_bit_cast(float, fa[q] & 0xffff0000u) + __builtin_bit_cast(float, ba[q] & 0xffff0000u);
            }
        }
#pragma unroll
        for (int i = 0; i < 16; ++i) ss += o[i] * o[i];
        ss += __shfl_xor(ss, 1, 64); ss += __shfl_xor(ss, 2, 64); ss += __shfl_xor(ss, 4, 64);
        const float rs = 1.0f / sqrtf(ss / 128.0f + EPS);
#pragma unroll
        for (int hh = 0; hh < 2; ++hh) {
            const v4u gz = *(const v4u*)(p.Z16 + (size_t)row * 8192 + 7 * 1024 + lane * 16 + 8 * hh);
            const unsigned ga[4] = {gz.x, gz.y, gz.z, gz.w};
            unsigned ow[4];
#pragma unroll
            for (int q = 0; q < 4; ++q) {
                const int c = lane * 16 + 8 * hh + 2 * q;
                const float g0 = __builtin_bit_cast(float, ga[q] << 16), g1 = __builtin_bit_cast(float, ga[q] & 0xffff0000u);
                ow[q] = pk2(o[8 * hh + 2 * q] * rs * p.hgrn_norm_g[c & 127] * siluf_(g0), o[8 * hh + 2 * q + 1] * rs * p.hgrn_norm_g[(c + 1) & 127] * siluf_(g1));
            }
            *(v4u*)(p.CAT + (size_t)row * D + 1024 + lane * 16 + 8 * hh) = (v4u){ow[0], ow[1], ow[2], ow[3]};
        }
    }
}
__device__ __forceinline__ void st_final(const int tid_, const Args& p) {
    const int lane = tid_ & 63, gw = blockIdx.x * NWAVES + (tid_ >> 6), nw = gridDim.x * NWAVES;
    for (int row = gw; row < TL; row += nw) {
        const float4* xr = (const float4*)(p.X + (size_t)row * D);
        float4 v[8];
        float ss = 0.f;
#pragma unroll
        for (int i = 0; i < 8; ++i) { v[i] = xr[lane + 64 * i]; ss += v[i].x * v[i].x + v[i].y * v[i].y + v[i].z * v[i].z + v[i].w * v[i].w; }
        ss = wave_sum(ss);
        const float rs = 1.0f / sqrtf(ss / D + EPS);
#pragma unroll
        for (int i = 0; i < 8; ++i) {
            const float4 gg = ((const float4*)p.final_g)[lane + 64 * i];
            ((float4*)(p.out + (size_t)row * D))[lane + 64 * i] = make_float4(v[i].x * rs * gg.x, v[i].y * rs * gg.y, v[i].z * rs * gg.z, v[i].w * rs * gg.w);
        }
    }
}

__global__ void __launch_bounds__(NT, 2) mega_fwd(Args p) {
    extern __shared__ __attribute__((aligned(16))) unsigned char lds_raw[];
    LAS unsigned char* ldsl = (LAS unsigned char*)lds_raw;
    float* lds = (float*)lds_raw;
    const int wave_id = __builtin_amdgcn_readfirstlane((int)threadIdx.x >> 6);
#define FT() fresh_tid(wave_id)
    volatile LAS unsigned* MISC = (volatile LAS unsigned*)(ldsl + MISC_OFF);
    for (int u = FT(); u < (LDS_BYTES - LDSCTL_OFF) / 4; u += NT) ((LAS unsigned*)(ldsl + LDSCTL_OFF))[u] = 0u;
    __syncthreads();
    XcdBarrier bar; bar.bar = p.ctl + CW_BAR; bar.x = 0; bar.st = nullptr;
    if (!MK_PER_PHASE) bar = xcd_barrier_post(p.ctl + CW_BAR, MISC + 8);
    const int lo = p.ph_lo, hi = p.ph_hi;
    const int Gd = (int)gridDim.x, bx = (int)blockIdx.x;
#ifndef PROBE_DUP
#define PROBE_DUP 0u
#endif
#define PH_BEGIN(k) if (lo <= (k) && (k) < hi) { for (int rep_ = 0; rep_ < (((PROBE_DUP >> (k)) & 1u) ? 2 : 1); ++rep_) {
#define PH_END(k) } if ((k) + 1 < hi) { if (!MK_PER_PHASE) xcd_barrier(bar, FT()); } }

    PH_BEGIN(0) { const int t0_ = FT(); if (bx == 0 && t0_ < 256) ((v4u*)(p.H + (size_t)T * D))[t0_] = (v4u){0u, 0u, 0u, 0u}; } st_weights(FT(), p, lds); st_ada(FT(), p, lds); PH_END(0)
    PH_BEGIN(1) st_router_prep(FT(), p); st_norm_mod(FT(), p, 0, T); PH_END(1)
    PH_BEGIN(2) { pg8::Gemm g{p.H, p.WinT0, T, 4096, D}; pg8::StaticOrder S; S.init(T, 4096, Gd, bx); pg8::EpiBf16 E{p.Z16, 4096, 16};
                  pg8::gemm_phase<pg8::EpiBf16, pg8::StaticOrder, PG8_ALIGN, PG8_SP2>(FT(), ldsl, g, S, E); } PH_END(2)
    PH_BEGIN(3) { const bool sw_ = ((bx >> 3) & 1) != 0;
                  if (sw_) st_l0_pre(FT(), p); st_l0_lru(FT(), p, lds); if (!sw_) st_l0_pre(FT(), p); } PH_END(3)
    PH_BEGIN(4) st_l0_carry(FT(), p); st_l0_conf(FT(), p, lds); PH_END(4)
    PH_BEGIN(5) st_l0_cat(FT(), p); PH_END(5)
    PH_BEGIN(6) { pg8::Gemm g{p.CAT, p.WoutT0, T, D, D}; pg8::StaticOrder S; S.init(T, D, Gd, bx); pg8::EpiResid E{(pg8::bf16_t*)p.X, p.x, p.ctx, p.MOD + 2 * D, 8, TL, D};
                  pg8::gemm_phase<pg8::EpiResid, pg8::StaticOrder, PG8_ALIGN, PG8_SP2>(FT(), ldsl, g, S, E); } PH_END(6)
    PH_BEGIN(7) st_post_mixer(FT(), p, 0, T, lds); PH_END(7)
    PH_BEGIN(8) st_topk(FT(), p, true, lds); st_norm_mod(FT(), p, 0, T, 1, Gd > 64 ? 64 : 0); PH_END(8)
    PH_BEGIN(9) { pg8::Gemm g{p.H, p.WupT, NE * MEP, NE * 4096, D}; pg8::GroupOrder S; S.init(9, 9, 16, NE, Gd, bx); S.list = p.LIST; S.lstride = ME; S.nslots = ME; S.zero_row = T; pg8::EpiSwiGLU E{p.HID, D, 16};
                   pg8::gemm_phase<pg8::EpiSwiGLU, pg8::GroupOrder, PG8_ALIGN, PG8_SP2, true>(FT(), ldsl, g, S, E); } PH_END(9)
    PH_BEGIN(10) { pg8::Gemm g{p.HID, p.WdnT, NE * MEP, NE * D, D}; pg8::GroupOrder S; S.init(9, 9, 8, NE, Gd, bx); S.list = nullptr; S.lstride = 0; S.nslots = 0; S.zero_row = 0; pg8::EpiBf16 E{p.Y16, D, 8};
                   pg8::gemm_phase<pg8::EpiBf16, pg8::GroupOrder, PG8_ALIGN, PG8_SP2>(FT(), ldsl, g, S, E); } PH_END(10)
    PH_BEGIN(11) st_combine<false>(FT(), p, 0, T); st_norm_mod(FT(), p, 1, T); PH_END(11)
    PH_BEGIN(12) { pg8::Gemm g{p.H, p.WinT1, T, 8192, D}; pg8::StaticOrder S; S.init(T, 8192, Gd, bx); pg8::EpiBf16 E{p.Z16, 8192, 32};
                   pg8::gemm_phase<pg8::EpiBf16, pg8::StaticOrder, PG8_ALIGN, PG8_SP2>(FT(), ldsl, g, S, E); } PH_END(12)
    PH_BEGIN(13) { const bool sw_ = ((bx >> 3) & 1) != 0;
                   if (sw_) st_hg_prep(FT(), p); st_vt(FT(), p, lds, 2, p.VT); st_vt(FT(), p, lds, 6, p.VT6); if (!sw_) st_hg_prep(FT(), p); } PH_END(13)
    PH_BEGIN(14) st_hg_seq(FT(), p, lds); st_na(FT(), p, lds); PH_END(14)
    PH_BEGIN(15) st_hgrn_out(FT(), p); PH_END(15)
    PH_BEGIN(16) { pg8::Gemm g{p.CAT, p.WoutT1, TL, D, D}; pg8::StaticOrder S; S.init(TL, D, Gd, bx); pg8::EpiResid E{(pg8::bf16_t*)p.X, nullptr, nullptr, p.MOD + (size_t)5 * 12288 + 2 * D, 8, TL, D};
                   pg8::gemm_phase<pg8::EpiResid, pg8::StaticOrder, PG8_ALIGN, PG8_SP2>(FT(), ldsl, g, S, E); } PH_END(16)
    PH_BEGIN(17) st_post_mixer(FT(), p, 1, TL, lds); PH_END(17)
    PH_BEGIN(18) st_topk(FT(), p, false, lds); st_norm_mod(FT(), p, 1, TL, 1, Gd > 64 ? 64 : 0); PH_END(18)
    PH_BEGIN(19) { pg8::Gemm g{p.H, p.WupT + (size_t)NE * 4096 * D, NE * MEP, NE * 4096, D}; pg8::GroupOrder S; S.init(8, 9, 16, NE, Gd, bx); S.list = p.LIST; S.lstride = ME; S.nslots = 2048; S.zero_row = T; pg8::EpiSwiGLU E{p.HID, D, 16};
                   pg8::gemm_phase<pg8::EpiSwiGLU, pg8::GroupOrder, PG8_ALIGN, PG8_SP2, true>(FT(), ldsl, g, S, E); } PH_END(19)
    PH_BEGIN(20) { pg8::Gemm g{p.HID, p.WdnT + (size_t)NE * D * D, NE * MEP, NE * D, D}; pg8::GroupOrder S; S.init(8, 9, 8, NE, Gd, bx); S.list = nullptr; S.lstride = 0; S.nslots = 0; S.zero_row = 0; pg8::EpiBf16 E{p.Y16, D, 8};
                   pg8::gemm_phase<pg8::EpiBf16, pg8::GroupOrder, PG8_ALIGN, PG8_SP2>(FT(), ldsl, g, S, E); } PH_END(20)
    PH_BEGIN(21) st_combine<true>(FT(), p, 1, TL); PH_END(21)
#undef PH_BEGIN
#undef PH_END
}
}

extern "C" void kernel_launch(void* const* d_in, const int* in_sizes, int n_in, void* d_out, int out_size, void* d_ws, size_t ws_size,
                              hipStream_t stream) {
    static int grid = 0;
    if (grid == 0) {
        int dev = 0, cus = 0;
        if (hipGetDevice(&dev) != hipSuccess || hipDeviceGetAttribute(&cus, hipDeviceAttributeMultiprocessorCount, dev) != hipSuccess) { fprintf(stderr, "kernel_launch: device query failed\n"); grid = -1; return; }
        if (hipFuncSetAttribute((const void*)mega_fwd, hipFuncAttributeMaxDynamicSharedMemorySize, LDS_BYTES) != hipSuccess) { fprintf(stderr, "kernel_launch: hipFuncSetAttribute failed\n"); grid = -1; return; }
        (void)hipGetLastError();
        grid = cus;
    }
    if (grid < 0) return;
    Args p{};
    const float** f = (const float**)&p;
    for (int i = 0; i < 30; ++i) f[i] = (const float*)d_in[i];
    p.out = (float*)d_out;
    char* w = (char*)d_ws;
    size_t off = 0;
    auto take = [&](size_t bytes) { void* r = w + off; off += (bytes + 255) & ~(size_t)255; return r; };
    p.ctl = (unsigned*)take(CTL_BYTES);
    p.WinT0 = (bf16*)take((size_t)4096 * D * 2);
    p.WoutT0 = (bf16*)take((size_t)D * D * 2);
    p.WinT1 = (bf16*)take((size_t)8192 * D * 2);
    p.WoutT1 = (bf16*)take((size_t)D * D * 2);
    p.WupT = (bf16*)take((size_t)2 * NE * 4096 * D * 2);
    p.WdnT = (bf16*)take((size_t)2 * NE * D * D * 2);
    p.X = (float*)take((size_t)T * D * 4);
    p.H = (bf16*)take((size_t)(T + 1) * D * 2);
    p.MOD = (float*)take((size_t)2 * 5 * 12288 * 4);
    p.AFF = (float*)take((size_t)T * NE * 4);
    p.SLOTOF = (int*)take((size_t)T * NE * 4);
    p.LIST = (int*)take((size_t)NE * ME * 4);
    p.GATEV = (float*)take((size_t)NE * ME * 4);
    p.TSP = (float*)take((size_t)(T / 64) * 2 * 1024 * 4);
    p.TSH = (float*)take((size_t)(T / 64) * 2 * 1024 * 4);
    p.CIN = (float*)take((size_t)(T / 64) * 2 * 1024 * 4);
    p.DEC = (float*)take((size_t)2 * (T / 16) * 1024 * 4);
    p.RTH = (bf16*)take((size_t)2 * 5 * NE * D * 2);
    p.RTL = (bf16*)take((size_t)2 * 5 * NE * D * 2);
    p.RBIAS = (float*)take((size_t)2 * 5 * NE * 4);
    const size_t scratch0 = off;
    p.Z = (float*)take((size_t)T * 8192 * 4);
    p.CAT = (bf16*)take((size_t)T * D * 2);
    p.O = (float*)take((size_t)T * D * 4);
    p.AB = (float*)take((size_t)T * G * 4);
    p.BB = (float*)take((size_t)T * G * 4);
    const size_t end_mixer = off;
    p.U = p.Z + (size_t)T * 4096;
    p.XL = p.U + (size_t)T * G;
    p.AF = p.XL + (size_t)T * G;
    p.BF = p.AF + (size_t)T * G;
    p.OF = p.AB; p.OB = p.BB;
    p.Z16 = (bf16*)p.Z;
    p.VT = (bf16*)(p.Z + (size_t)T * 4096);
    p.VT6 = p.VT + (size_t)32 * 128 * 4352;
    p.KHT = p.VT6 + (size_t)32 * 128 * 4352;
    p.QT = p.KHT + (size_t)2 * 32 * 128 * 4352;
    p.KT = p.QT + (size_t)2 * T * 1024;
    off = scratch0;
    p.XS = (bf16*)take((size_t)NE * MEP * D * 2);
    p.HID = (bf16*)take((size_t)NE * MEP * D * 2);
    p.Y16 = (bf16*)take((size_t)NE * MEP * D * 2); p.Y = nullptr;
    const size_t need = off > end_mixer ? off : end_mixer;
    if (need > ws_size) { fprintf(stderr, "kernel_launch: workspace too small: need %zu have %zu\n", need, ws_size); return; }
    (void)in_sizes; (void)n_in; (void)out_size;
    if (hipMemsetAsync(p.ctl, 0, CTL_BYTES, stream) != hipSuccess) { fprintf(stderr, "kernel_launch: memset failed\n"); return; }
#if MK_PER_PHASE
    for (int k = 0; k < NPHASES; ++k) { p.ph_lo = k; p.ph_hi = k + 1; hipLaunchKernelGGL(mega_fwd, dim3(grid), dim3(NT), LDS_BYTES, stream, p); }
#else
    p.ph_lo = 0; p.ph_hi = NPHASES;
    hipLaunchKernelGGL(mega_fwd, dim3(grid), dim3(NT), LDS_BYTES, stream, p);
#endif
    const hipError_t le = hipPeekAtLastError();
    if (le != hipSuccess) fprintf(stderr, "kernel_launch: launch failed: %s\n", hipGetErrorName(le));
}
```

```cpp
#include <hip/hip_runtime.h>
#include <cstdio>
#include <cstdint>
#define LAS __attribute__((address_space(3)))

namespace pg8 {
#define PG8_LAS __attribute__((address_space(3)))
typedef unsigned short bf16_t;
typedef short bf16x8 __attribute__((ext_vector_type(8)));
typedef float f32x4 __attribute__((ext_vector_type(4)));
typedef unsigned u32x4 __attribute__((ext_vector_type(4)));
constexpr int BM = 256, BK = 64, HALF = 128, HTB = HALF * BK * 2  , STAGE_BYTES = 8 * HTB, NXCD = 8, WGM = 8;

__host__ __device__ __forceinline__ int lds_byte(int r, int c) { const int st = (r >> 4) * 2 + (c >> 5), rr = r & 15, cc = c & 31, ob = rr * 64 + cc * 2; return st * 1024 + (ob ^ (((ob >> 9) & 1) << 5)); }
__host__ __device__ __forceinline__ void stage_rc(int b, int& R, int& C) { const int st = b / 1024, sb = b % 1024, swz = sb ^ (((sb >> 9) & 1) << 5); R = (st >> 1) * 16 + swz / 64; C = (st & 1) * 32 + (swz % 64) / 2; }
__host__ __device__ __forceinline__ int perm32(int rho) { const int n = rho >> 4, i = rho & 15; return 8 * (i >> 2) + 4 * n + (i & 3); }

struct Unit { int pm, pn; };
struct Gemm { const bf16_t* A; const bf16_t* Bt; int M, N, K; };

struct StaticOrder {
    int nM, nN, nwg, G, c;
    __host__ __device__ void init(int M, int N, int G_, int c_) { nM = M / BM; nN = N / BM; nwg = nM * nN; G = G_; c = c_; }
    __host__ __device__ bool next(int i, Unit& u) const {
        const long L = (long)i * G + c; if (L >= nwg) return false;
        int wgid = (int)L; { const int q = nwg / NXCD, r = nwg % NXCD, xcd = wgid % NXCD, off = wgid / NXCD; wgid = (xcd < r ? xcd * (q + 1) : r * (q + 1) + (xcd - r) * q) + off; }
        const int nig = WGM * nN, gid = wgid / nig, fm = gid * WGM, gsz = (nM - fm) < WGM ? (nM - fm) : WGM;
        u.pm = fm + ((wgid % nig) % gsz); u.pn = (wgid % nig) / gsz; return true;
    }
    __device__ __forceinline__ void a_ready(const Unit&) const {}
    __device__ __forceinline__ void done(const Unit&) const {}
};


__device__ __forceinline__ unsigned cvt_pk_bf16(float lo, float hi) { unsigned r; asm volatile("v_cvt_pk_bf16_f32 %0, %1, %2" : "=v"(r) : "v"(lo), "v"(hi)); return r; }


struct EpiF32 {
    static constexpr bool PERM = false, AFTER_DRAIN = false;
    float* C; int ldc; int colmod;
    __device__ __forceinline__ void operator()(const f32x4 (&acc)[2][2][4][2], const Unit& u, int wr, int wc, int fr, int fq) const {
        const int row0 = u.pm * BM + wr * 64 + fr, col0 = (u.pn % colmod) * BM + wc * 32 + 4 * fq;
#pragma unroll
        for (int ai = 0; ai < 2; ++ai)
#pragma unroll
            for (int m = 0; m < 4; ++m) { float* rowp = C + (size_t)(row0 + ai * HALF + m * 16) * ldc + col0;
#pragma unroll
                for (int bj = 0; bj < 2; ++bj)
#pragma unroll
                    for (int n = 0; n < 2; ++n) *(f32x4*)(rowp + bj * HALF + n * 16) = acc[ai][bj][m][n]; }
    }
};
struct EpiResid {
    static constexpr bool PERM = true, AFTER_DRAIN = false;
    bf16_t* X; const float* xlat; const float* xctx; const float* mod; int colmod; int TLrows; int ldx;
    __device__ __forceinline__ void operator()(const f32x4 (&acc)[2][2][4][2], const Unit& u, int wr, int wc, int fr, int fq) const {
        const int row0 = u.pm * BM + wr * 64 + fr, col0 = (u.pn % colmod) * BM + wc * 32 + 8 * fq;
        const bool lat = u.pm * BM < TLrows;
        const int mrow = lat ? (u.pm >> 4) : 4;
        const float* md = mod + (size_t)mrow * 12288 + col0;
        const float* sbase = xlat ? (lat ? xlat : xctx - (size_t)TLrows * ldx) : nullptr;
#pragma unroll
        for (int bj = 0; bj < 2; ++bj) {
            const f32x4 g0 = *(const f32x4*)(md + bj * HALF), g1 = *(const f32x4*)(md + bj * HALF + 4);
#pragma unroll
            for (int ai = 0; ai < 2; ++ai)
#pragma unroll
                for (int m = 0; m < 4; ++m) {
                    const size_t o = (size_t)(row0 + ai * HALF + m * 16) * ldx + col0 + bj * HALF;
                    f32x4 s0, s1;
                    if (sbase) { s0 = *(const f32x4*)(sbase + o); s1 = *(const f32x4*)(sbase + o + 4); }
                    else { const u32x4 w = *(const u32x4*)(X + o);
                        s0 = (f32x4){__builtin_bit_cast(float, w.x << 16), __builtin_bit_cast(float, w.x & 0xffff0000u), __builtin_bit_cast(float, w.y << 16), __builtin_bit_cast(float, w.y & 0xffff0000u)};
                        s1 = (f32x4){__builtin_bit_cast(float, w.z << 16), __builtin_bit_cast(float, w.z & 0xffff0000u), __builtin_bit_cast(float, w.w << 16), __builtin_bit_cast(float, w.w & 0xffff0000u)}; }
                    const f32x4 r0 = s0 + g0 * acc[ai][bj][m][0], r1 = s1 + g1 * acc[ai][bj][m][1];
                    u32x4 w; w.x = cvt_pk_bf16(r0[0], r0[1]); w.y = cvt_pk_bf16(r0[2], r0[3]); w.z = cvt_pk_bf16(r1[0], r1[1]); w.w = cvt_pk_bf16(r1[2], r1[3]);
                    *(u32x4*)(X + o) = w;
                }
        }
    }
};
struct EpiBf16 {
    static constexpr bool PERM = true, AFTER_DRAIN = false;
    bf16_t* O; int ldc; int colmod;
    __device__ __forceinline__ void operator()(const f32x4 (&acc)[2][2][4][2], const Unit& u, int wr, int wc, int fr, int fq) const {
        const int row0 = u.pm * BM + wr * 64 + fr, col0 = (u.pn % colmod) * BM + wc * 32 + 8 * fq;
#pragma unroll
        for (int ai = 0; ai < 2; ++ai)
#pragma unroll
            for (int m = 0; m < 4; ++m) { bf16_t* rowp = O + (size_t)(row0 + ai * HALF + m * 16) * ldc + col0;
#pragma unroll
                for (int bj = 0; bj < 2; ++bj) { const f32x4 v0 = acc[ai][bj][m][0], v1 = acc[ai][bj][m][1];
                    u32x4 w; w.x = cvt_pk_bf16(v0[0], v0[1]); w.y = cvt_pk_bf16(v0[2], v0[3]); w.z = cvt_pk_bf16(v1[0], v1[1]); w.w = cvt_pk_bf16(v1[2], v1[3]);
                    *(u32x4*)(rowp + bj * HALF) = w; } }
    }
};
struct EpiSwiGLU {
    static constexpr bool PERM = true, AFTER_DRAIN = false;
    bf16_t* O; int ldc; int colmod;
    __device__ __forceinline__ void operator()(const f32x4 (&acc)[2][2][4][2], const Unit& u, int wr, int wc, int fr, int fq) const {
        const int row0 = u.pm * BM + wr * 64 + fr, col0 = (u.pn % colmod) * HALF + wc * 32 + 8 * fq;
#pragma unroll
        for (int ai = 0; ai < 2; ++ai)
#pragma unroll
            for (int m = 0; m < 4; ++m) { bf16_t* rowp = O + (size_t)(row0 + ai * HALF + m * 16) * ldc + col0;
                float h[8];
#pragma unroll
                for (int n = 0; n < 2; ++n)
#pragma unroll
                    for (int i = 0; i < 4; ++i) { const float g = acc[ai][0][m][n][i], v = acc[ai][1][m][n][i]; h[n * 4 + i] = g * __builtin_amdgcn_rcpf(1.0f + __expf(-g)) * v; }
                u32x4 w; w.x = cvt_pk_bf16(h[0], h[1]); w.y = cvt_pk_bf16(h[2], h[3]); w.z = cvt_pk_bf16(h[4], h[5]); w.w = cvt_pk_bf16(h[6], h[7]);
                *(u32x4*)rowp = w; }
    }
};
struct GroupOrder {
    int nM, nMs, nN, nE, nwg, G, c;
    const int* list; int lstride, nslots, zero_row;
    __device__ __forceinline__ int a_row(const Unit& u, int r) const { const int e = u.pm / nMs, slot = (u.pm - e * nMs) * BM + r; return slot < nslots ? list[e * lstride + slot] : zero_row; }
    __host__ __device__ void init(int nM_, int nMs_, int nN_, int nE_, int G_, int c_) { nM = nM_; nMs = nMs_; nN = nN_; nE = nE_; nwg = nM * nN * nE; G = G_; c = c_; }
    __host__ __device__ bool next(int i, Unit& u) const {
        const long L = (long)i * G + c; if (L >= nwg) return false;
        int wgid = (int)L; { const int q = nwg / NXCD, r = nwg % NXCD, xcd = wgid % NXCD, off = wgid / NXCD; wgid = (xcd < r ? xcd * (q + 1) : r * (q + 1) + (xcd - r) * q) + off; }
        const int per = nM * nN, e = wgid / per, r2 = wgid % per, tn = r2 / nM, tm = r2 % nM;
        u.pm = e * nMs + tm; u.pn = e * nN + tn; return true;
    }
    __device__ __forceinline__ void a_ready(const Unit&) const {}
    __device__ __forceinline__ void done(const Unit&) const {}
};

template <class Epi, class Sched, bool ALIGN_EPI = false, bool SP2 = false, bool GATHER = false>
__device__ __forceinline__ void gemm_phase(const int tid_in, PG8_LAS unsigned char* lds, const Gemm g, const Sched& S, const Epi& E) {
    const int tid = tid_in, wid = __builtin_amdgcn_readfirstlane(tid >> 6), lane = tid & 63, wr = wid >> 2, wc = wid & 3, fr = lane & 15, fq = lane >> 4;
    const int K = g.K, nt = K / BK;
    unsigned voffA[2], voffB[2]; int RA[2], CA[2];
#pragma unroll
    for (int i = 0; i < 2; ++i) { int R, C; stage_rc(tid * 16 + i * 8192, R, C); const int Rb = Epi::PERM ? ((R & ~31) + perm32(R & 31)) : R;
        voffA[i] = (unsigned)(R * K + C) * 2u; voffB[i] = (unsigned)(Rb * K + C) * 2u; RA[i] = R; CA[i] = C; }
    static_assert(!GATHER || SP2, "GATHER is wired into the SP2 loop only");
    unsigned gA[2][2] = {{0u, 0u}, {0u, 0u}}, gN[2][2] = {{0u, 0u}, {0u, 0u}};
#define PG8_GOFF(VO, un) do { _Pragma("unroll") for (int _h = 0; _h < 2; ++_h) _Pragma("unroll") for (int _i = 0; _i < 2; ++_i) \
        VO[_h][_i] = (unsigned)(S.a_row(un, _h * HALF + RA[_i]) * K + CA[_i]) * 2u; } while (0)
#define PG8_STAGE_G(bufoff, kbyte, VOH) do { _Pragma("unroll") for (int _i = 0; _i < 2; ++_i) \
        __builtin_amdgcn_global_load_lds((const unsigned*)((const char*)g.A + (kbyte) + (VOH)[_i]), (PG8_LAS unsigned*)(lds + (bufoff) + ldsw + _i * 8192), 16, 0, 0); } while (0)
    const size_t kstep = (size_t)(BK * 2);
    const size_t hstep = (size_t)HALF * K * 2;
    const size_t tstep = 2 * hstep;
    const unsigned ldsw = (unsigned)wid * 1024u;
    const int aoff = lds_byte(wr * 64 + fr, fq * 8), boff = lds_byte(wc * 32 + fr, fq * 8);
#define PG8_SA(b, h) (((b) * 2 + (h)) * HTB)
#define PG8_SB(b, h) ((4 + (b) * 2 + (h)) * HTB)
#define PG8_STAGE(bufoff, gbase, voff) do { _Pragma("unroll") for (int _i = 0; _i < 2; ++_i) \
        __builtin_amdgcn_global_load_lds((const unsigned*)((const char*)(gbase) + (voff)[_i]), (PG8_LAS unsigned*)(lds + (bufoff) + ldsw + _i * 8192), 16, 0, 0); } while (0)
#define PG8_LDA(dst, b, h) do { _Pragma("unroll") for (int m = 0; m < 4; ++m) _Pragma("unroll") for (int k = 0; k < 2; ++k) dst[m][k] = *(const PG8_LAS bf16x8*)(lds + PG8_SA(b, h) + aoff + m * 2048 + k * 1024); } while (0)
#define PG8_LDB(dst, b, h) do { _Pragma("unroll") for (int n = 0; n < 2; ++n) _Pragma("unroll") for (int k = 0; k < 2; ++k) dst[n][k] = *(const PG8_LAS bf16x8*)(lds + PG8_SB(b, h) + boff + n * 2048 + k * 1024); } while (0)
#define PG8_MMA(ai, bj, At, Bt) do { __builtin_amdgcn_s_setprio(1); _Pragma("unroll") for (int m = 0; m < 4; ++m) _Pragma("unroll") for (int n = 0; n < 2; ++n) _Pragma("unroll") for (int k = 0; k < 2; ++k) \
        acc[ai][bj][m][n] = __builtin_amdgcn_mfma_f32_16x16x32_bf16(Bt[n][k], At[m][k], acc[ai][bj][m][n], 0, 0, 0); __builtin_amdgcn_s_setprio(0); } while (0)
#define PG8_WAIT_V(n) asm volatile("s_waitcnt vmcnt(" #n ")" ::: "memory")
#define PG8_WAIT_L(n) asm volatile("s_waitcnt lgkmcnt(" #n ")" ::: "memory")
#define PG8_BAR __builtin_amdgcn_s_barrier()
#define PG8_SCHED __builtin_amdgcn_sched_barrier(0)
    Unit cur, nxt; int ui = 0;
    if (!S.next(0, cur)) return;
    f32x4 acc[2][2][4][2];
#pragma unroll
    for (int a = 0; a < 2; ++a)
#pragma unroll
        for (int b = 0; b < 2; ++b)
#pragma unroll
            for (int m = 0; m < 4; ++m)
#pragma unroll
                for (int n = 0; n < 2; ++n) acc[a][b][m][n] = (f32x4){0.f, 0.f, 0.f, 0.f};
    bf16x8 At[4][2], B0[2][2], B1[2][2];
    const char* cA = (const char*)g.A + (size_t)cur.pm * tstep; const char* cB = (const char*)g.Bt + (size_t)cur.pn * tstep;
    S.a_ready(cur);
    if constexpr (SP2) {
        if constexpr (GATHER) PG8_GOFF(gA, cur);
        PG8_STAGE(PG8_SB(0, 0), cB, voffB); PG8_STAGE(PG8_SB(0, 1), cB + hstep, voffB);
        if constexpr (GATHER) { PG8_STAGE_G(PG8_SA(0, 0), 0, gA[0]); PG8_STAGE_G(PG8_SA(0, 1), 0, gA[1]); } else { PG8_STAGE(PG8_SA(0, 0), cA, voffA); PG8_STAGE(PG8_SA(0, 1), cA + hstep, voffA); }
        if (wr == 1) PG8_BAR;
        PG8_WAIT_V(2); PG8_BAR;
        PG8_STAGE(PG8_SB(1, 0), cB + kstep, voffB);
        if constexpr (GATHER) PG8_STAGE_G(PG8_SA(1, 0), kstep, gA[0]); else PG8_STAGE(PG8_SA(1, 0), cA + kstep, voffA);
        PG8_STAGE(PG8_SB(1, 1), cB + hstep + kstep, voffB);
        PG8_WAIT_V(6); PG8_BAR;
    } else {
        PG8_STAGE(PG8_SB(0, 0), cB, voffB); PG8_STAGE(PG8_SA(0, 0), cA, voffA); PG8_STAGE(PG8_SB(0, 1), cB + hstep, voffB); PG8_STAGE(PG8_SA(0, 1), cA + hstep, voffA);
        if (wr == 1) PG8_BAR;
        PG8_WAIT_V(4); PG8_BAR;
        PG8_STAGE(PG8_SB(1, 0), cB + kstep, voffB); PG8_STAGE(PG8_SA(1, 0), cA + kstep, voffA); PG8_STAGE(PG8_SB(1, 1), cB + hstep + kstep, voffB);
        PG8_WAIT_V(6); PG8_BAR;
    }
    for (;;) {
        const bool has_next = S.next(ui + 1, nxt);
        const char* nA = has_next ? (const char*)g.A + (size_t)nxt.pm * tstep : cA; const char* nB = has_next ? (const char*)g.Bt + (size_t)nxt.pn * tstep : cB;
        if constexpr (GATHER) { if (has_next) PG8_GOFF(gN, nxt); else { _Pragma("unroll") for (int _h = 0; _h < 2; ++_h) _Pragma("unroll") for (int _i = 0; _i < 2; ++_i) gN[_h][_i] = gA[_h][_i]; } }
        for (int t = 0; t < nt; t += 2) {
            const bool last = (t == nt - 2);
            const char* a1 = cA + (size_t)(t + 1) * kstep;
            const char* a2 = last ? nA : cA + (size_t)(t + 2) * kstep; const char* b2 = last ? nB : cB + (size_t)(t + 2) * kstep;
            const char* a3 = a2 + kstep; const char* b3 = b2 + kstep;
            const size_t k1b = (size_t)(t + 1) * kstep, k2b = last ? 0 : (size_t)(t + 2) * kstep, k3b = k2b + kstep;
            unsigned g2[2][2];
            if constexpr (GATHER) { _Pragma("unroll") for (int _h = 0; _h < 2; ++_h) _Pragma("unroll") for (int _i = 0; _i < 2; ++_i) g2[_h][_i] = last ? gN[_h][_i] : gA[_h][_i]; }
            (void)k1b; (void)k2b; (void)k3b; (void)g2;
            if (last && has_next) S.a_ready(nxt);
            if constexpr (SP2) {
            PG8_LDB(B0, 0, 0); PG8_LDB(B1, 0, 1); PG8_SCHED; PG8_LDA(At, 0, 0); if constexpr (GATHER) PG8_STAGE_G(PG8_SA(1, 1), k1b, gA[1]); else PG8_STAGE(PG8_SA(1, 1), a1 + hstep, voffA);
            PG8_WAIT_V(8); PG8_WAIT_L(0); PG8_BAR; PG8_MMA(0, 0, At, B0); PG8_MMA(0, 1, At, B1); PG8_BAR; PG8_SCHED;
            PG8_LDA(At, 0, 1); PG8_STAGE(PG8_SB(0, 0), b2, voffB); PG8_STAGE(PG8_SB(0, 1), b2 + hstep, voffB); if constexpr (GATHER) PG8_STAGE_G(PG8_SA(0, 0), k2b, g2[0]); else PG8_STAGE(PG8_SA(0, 0), a2, voffA);
            PG8_WAIT_V(8); PG8_WAIT_L(0); PG8_BAR; PG8_MMA(1, 0, At, B0); PG8_MMA(1, 1, At, B1); PG8_BAR; PG8_SCHED;
            PG8_LDB(B0, 1, 0); PG8_LDB(B1, 1, 1); PG8_SCHED; PG8_LDA(At, 1, 0); if constexpr (GATHER) PG8_STAGE_G(PG8_SA(0, 1), k2b, g2[1]); else PG8_STAGE(PG8_SA(0, 1), a2 + hstep, voffA);
            PG8_WAIT_V(8); PG8_WAIT_L(0); PG8_BAR; PG8_MMA(0, 0, At, B0); PG8_MMA(0, 1, At, B1); PG8_BAR; PG8_SCHED;
            PG8_LDA(At, 1, 1); PG8_STAGE(PG8_SB(1, 0), b3, voffB); PG8_STAGE(PG8_SB(1, 1), b3 + hstep, voffB); if constexpr (GATHER) PG8_STAGE_G(PG8_SA(1, 0), k3b, g2[0]); else PG8_STAGE(PG8_SA(1, 0), a3, voffA);
            PG8_WAIT_V(8); PG8_WAIT_L(0); PG8_BAR; PG8_MMA(1, 0, At, B0); PG8_MMA(1, 1, At, B1); PG8_BAR; PG8_SCHED;
            } else {
            PG8_LDB(B0, 0, 0); PG8_SCHED; PG8_LDA(At, 0, 0); PG8_STAGE(PG8_SA(1, 1), a1 + hstep, voffA);
            PG8_WAIT_L(8); PG8_BAR; PG8_WAIT_L(0); PG8_MMA(0, 0, At, B0); PG8_BAR; PG8_SCHED;
            PG8_LDB(B1, 0, 1); PG8_STAGE(PG8_SB(0, 0), b2, voffB);
            PG8_BAR; PG8_WAIT_L(0); PG8_MMA(0, 1, At, B1); PG8_BAR;
            PG8_LDA(At, 0, 1); PG8_STAGE(PG8_SA(0, 0), a2, voffA);
            PG8_BAR; PG8_WAIT_L(0); PG8_MMA(1, 0, At, B0); PG8_BAR; PG8_SCHED;
            PG8_STAGE(PG8_SB(0, 1), b2 + hstep, voffB);
            PG8_WAIT_V(6); PG8_BAR; PG8_MMA(1, 1, At, B1); PG8_BAR;
            PG8_LDB(B0, 1, 0); PG8_SCHED; PG8_LDA(At, 1, 0); PG8_STAGE(PG8_SA(0, 1), a2 + hstep, voffA);
            PG8_WAIT_L(8); PG8_BAR; PG8_WAIT_L(0); PG8_MMA(0, 0, At, B0); PG8_BAR; PG8_SCHED;
            PG8_LDB(B1, 1, 1); PG8_STAGE(PG8_SB(1, 0), b3, voffB);
            PG8_BAR; PG8_WAIT_L(0); PG8_MMA(0, 1, At, B1); PG8_BAR;
            PG8_LDA(At, 1, 1); PG8_STAGE(PG8_SA(1, 0), a3, voffA);
            PG8_BAR; PG8_WAIT_L(0); PG8_MMA(1, 0, At, B0); PG8_BAR; PG8_SCHED;
            PG8_STAGE(PG8_SB(1, 1), b3 + hstep, voffB);
            PG8_WAIT_V(6); PG8_BAR; PG8_MMA(1, 1, At, B1); PG8_BAR;
            }
        }
        if constexpr (ALIGN_EPI) { if (wr == 0) PG8_BAR; }
        if constexpr (!Epi::AFTER_DRAIN) { E(acc, cur, wr, wc, fr, fq); S.done(cur); }
        if (!has_next) break;
#pragma unroll
        for (int a = 0; a < 2; ++a)
#pragma unroll
            for (int b = 0; b < 2; ++b)
#pragma unroll
                for (int m = 0; m < 4; ++m)
#pragma unroll
                    for (int n = 0; n < 2; ++n) acc[a][b][m][n] = (f32x4){0.f, 0.f, 0.f, 0.f};
        cur = nxt; cA = nA; cB = nB; ++ui;
        if constexpr (GATHER) { _Pragma("unroll") for (int _h = 0; _h < 2; ++_h) _Pragma("unroll") for (int _i = 0; _i < 2; ++_i) gA[_h][_i] = gN[_h][_i]; }
        if constexpr (ALIGN_EPI) { if (wr == 1) PG8_BAR; }
    }
    PG8_WAIT_V(0);
    if constexpr (!ALIGN_EPI) { if (wr == 0) PG8_BAR; }
    PG8_BAR;
    if constexpr (Epi::AFTER_DRAIN) { E.fused(acc, cur, wr, wc, fr, fq, lds, wid, lane); S.done(cur); }
#undef PG8_GOFF
#undef PG8_STAGE_G
#undef PG8_SA
#undef PG8_SB
#undef PG8_STAGE
#undef PG8_LDA
#undef PG8_LDB
#undef PG8_MMA
#undef PG8_WAIT_V
#undef PG8_WAIT_L
#undef PG8_BAR
#undef PG8_SCHED
}
}

#define XB_TMO      128
#define XB_XCNT(j)  (256  + 64 * (j))
#define XB_XSUB(j)  (1280 + 64 * (j))
#define XB_XGEN(j)  (2304 + 64 * (j))
#define XB_TOP      3328
#define XB_TOPGEN   3392
#define XCD_BAR_WORDS 3456
#define XB_SPIN_CAP (1u << 18)

__device__ __forceinline__ unsigned xb_ld(unsigned* p)              { return __hip_atomic_load(p, __ATOMIC_RELAXED, __HIP_MEMORY_SCOPE_AGENT); }
__device__ __forceinline__ unsigned xb_add(unsigned* p, unsigned v) { return __hip_atomic_fetch_add(p, v, __ATOMIC_RELAXED, __HIP_MEMORY_SCOPE_AGENT); }
__device__ __forceinline__ unsigned xb_xcc_id() { return (unsigned)__builtin_amdgcn_s_getreg((3 << 11) | 20) & 0xFu; }
#define XB_SPIN(cond, bar) do { unsigned _sp = 0; while (cond) { __builtin_amdgcn_s_sleep(1); \
    if ((++_sp & 255u) == 0u) { if (xb_ld(&(bar)[XB_TMO])) break; if (_sp > XB_SPIN_CAP) { atomicAdd(&(bar)[XB_TMO], 1u); break; } } } } while (0)

struct XcdBarrier {
    unsigned* bar; unsigned x;
    volatile LAS unsigned* st;
};

__device__ __forceinline__ XcdBarrier xcd_barrier_post(unsigned* bar, volatile LAS unsigned* st) {
    XcdBarrier b; b.bar = bar; b.x = xb_xcc_id(); b.st = st;
    if (threadIdx.x == 0) (void)xb_add(&bar[XB_XCNT(b.x)], 1u);
    return b;
}
__device__ __forceinline__ void xcd_barrier_complete(unsigned* bar, unsigned x, unsigned& nloc, unsigned& nx) {
    const unsigned G = gridDim.x * gridDim.y * gridDim.z;
    unsigned sum, cnt, mine, sp = 0u;
    for (;;) {
        sum = 0u; cnt = 0u; mine = 0u;
#pragma unroll
        for (unsigned j = 0; j < 16; ++j) { const unsigned c = xb_ld(&bar[XB_XCNT(j)]); sum += c; cnt += (c > 0u) ? 1u : 0u; mine = (j == x) ? c : mine; }
        if (sum == G) break;
        __builtin_amdgcn_s_sleep(1);
        if ((++sp & 255u) == 0u) { if (xb_ld(&bar[XB_TMO])) break; if (sp > XB_SPIN_CAP) { atomicAdd(&bar[XB_TMO], 1u); break; } }
    }
    nloc = mine > 0u ? mine : 1u; nx = cnt > 0u ? cnt : 1u;
}

__device__ __forceinline__ void xcd_barrier(const XcdBarrier& b, const int tid_) {
    asm volatile("s_waitcnt vmcnt(0)" ::: "memory");
    __syncthreads();
    if (tid_ == 0) {
        unsigned* bar = b.bar;
        __builtin_amdgcn_s_waitcnt(0);
        unsigned nloc = b.st[0], nx = b.st[1];
        if (nloc == 0u) { xcd_barrier_complete(bar, b.x, nloc, nx); b.st[0] = nloc; b.st[1] = nx; }
        const unsigned old = xb_add(&bar[XB_XSUB(b.x)], 1u);
        const unsigned gen = old / nloc;
        if (old + 1u == (gen + 1u) * nloc) {
            __builtin_amdgcn_fence(__ATOMIC_RELEASE, "agent");
            asm volatile("s_waitcnt vmcnt(0)" ::: "memory");
            const unsigned og = xb_add(&bar[XB_TOP], 1u);
            const unsigned tg = og / nx;
            if (og + 1u == (tg + 1u) * nx) xb_add(&bar[XB_TOPGEN], 1u);
            else XB_SPIN(xb_ld(&bar[XB_TOPGEN]) == tg, bar);
            __builtin_amdgcn_fence(__ATOMIC_ACQUIRE, "agent");
            xb_add(&bar[XB_XGEN(b.x)], 1u);
            asm volatile("s_waitcnt vmcnt(0)" ::: "memory");
        } else {
            XB_SPIN(xb_ld(&bar[XB_XGEN(b.x)]) == gen, bar);
            __builtin_amdgcn_fence(__ATOMIC_ACQUIRE, "agent");
            asm volatile("s_waitcnt vmcnt(0)" ::: "memory");
        }
    }
    __syncthreads();
}


namespace {
#define GAS __attribute__((address_space(1)))
typedef unsigned short bf16;
typedef unsigned v4u __attribute__((ext_vector_type(4)));
typedef unsigned v2u __attribute__((ext_vector_type(2)));
typedef short bf16x8_t __attribute__((ext_vector_type(8)));
typedef float f32x4_t __attribute__((ext_vector_type(4)));
typedef float f32x2_t __attribute__((ext_vector_type(2)));

constexpr int D = 2048, NB = 4, SEQ = 4096, CTXL = 256, G = 1024;
constexpr int TL = NB * SEQ, TC = NB * CTXL, T = TL + TC;
constexpr int NE = 16, ME = 2176, MEP = 2304;
constexpr int NT = 512, NWAVES = 8;
constexpr float EPS = 1e-6f;
constexpr int RING_BYTES = 131072, LDSCTL_OFF = RING_BYTES, MISC_OFF = LDSCTL_OFF + 320, LDS_BYTES = 147456;
constexpr size_t CTL_BYTES = 1u << 20;
constexpr int CW_BAR = 4096;
#ifndef MK_PER_PHASE
#define MK_PER_PHASE 0
#endif
constexpr int NPHASES = 22;
#ifndef PG8_SP2
#define PG8_SP2 true
#endif
#ifndef PG8_ALIGN
#define PG8_ALIGN true
#endif

struct Args {
    const float *x, *c, *ctx, *c_ctx, *ada_w, *ada_b, *norm_g, *final_g, *ab_w_in, *ab_w_out,
        *conf_dw_w, *conf_dw_b, *conf_ln_g, *conf_ln_b, *lru_conv_w, *lru_conv_b, *lru_wa, *lru_ba,
        *lru_wi, *lru_bi, *lru_lam, *cd_w_in, *cd_w_out, *na_bias, *hgrn_lb, *hgrn_norm_g,
        *moe_router, *moe_w1, *moe_w3, *moe_w2;
    float* out;
    unsigned* ctl;
    bf16 *WinT0, *WoutT0, *WinT1, *WoutT1, *WupT, *WdnT;
    float *X, *MOD, *AFF, *GATEV;
    int *SLOTOF, *LIST;
    bf16 *H, *CAT, *XS, *HID, *Z16, *VT, *VT6, *Y16, *QT, *KT, *KHT, *RTH, *RTL;
    float *Z, *O, *U, *XL, *AF, *BF, *AB, *BB, *OF, *OB, *Y, *TSP, *TSH, *CIN, *DEC, *RBIAS;
    int ph_lo, ph_hi;
};

__device__ __forceinline__ int fresh_tid(int wid) { int l; asm volatile("v_mbcnt_lo_u32_b32 %0, -1, 0\n\tv_mbcnt_hi_u32_b32 %0, -1, %0" : "=v"(l)); return wid * 64 + l; }
__device__ __forceinline__ float sigmoidf_(float v) { return __builtin_amdgcn_rcpf(1.0f + __expf(-v)); }
__device__ __forceinline__ float siluf_(float v) { return v * __builtin_amdgcn_rcpf(1.0f + __expf(-v)); }
__device__ __forceinline__ float wave_sum(float v) {
#pragma unroll
    for (int o = 32; o >= 1; o >>= 1) v += __shfl_xor(v, o, 64);
    return v;
}
typedef __bf16 bf16x2v_t __attribute__((ext_vector_type(2)));
__device__ __forceinline__ unsigned cvtpk(float lo, float hi) { const f32x2_t v = {lo, hi}; const bf16x2v_t b = __builtin_convertvector(v, bf16x2v_t); return __builtin_bit_cast(unsigned, b); }
__device__ __forceinline__ unsigned f2bf(float f) { return cvtpk(f, 0.f) & 0xffffu; }
__device__ __forceinline__ float bf2f(bf16 v) { return __builtin_bit_cast(float, (unsigned)v << 16); }
__device__ __forceinline__ unsigned pk2(float lo, float hi) { return cvtpk(lo, hi); }
__device__ __forceinline__ float4 ldx4(const bf16* q) { const v2u w = *(const v2u*)q; return make_float4(__builtin_bit_cast(float, w.x << 16), __builtin_bit_cast(float, w.x & 0xffff0000u), __builtin_bit_cast(float, w.y << 16), __builtin_bit_cast(float, w.y & 0xffff0000u)); }
__device__ __forceinline__ void stx4(bf16* q, const float4 v) { v2u o; o.x = pk2(v.x, v.y); o.y = pk2(v.z, v.w); *(v2u*)q = o; }
__device__ __forceinline__ int mod_row(int row) { return row < TL ? (row >> 12) : 4; }
__device__ __forceinline__ void seq_pos(int row, int& n, int& len) {
    if (row < TL) { n = row & (SEQ - 1); len = SEQ; } else { n = (row - TL) & (CTXL - 1); len = CTXL; }
}

__device__ __forceinline__ void transpose_item(const float* W, int K, int N, bf16* WT, int k0, int n0, int drow0, float* scr, int lane) {
#pragma unroll 8
    for (int i = 0; i < 32; ++i) { const int kk = 2 * i + (lane >> 5); scr[kk * 33 + (lane & 31)] = __builtin_nontemporal_load(W + (size_t)(k0 + kk) * N + n0 + (lane & 31)); }
    asm volatile("s_waitcnt lgkmcnt(0)" ::: "memory");
    const int c = lane & 7;
#pragma unroll
    for (int j = 0; j < 4; ++j) { const int n = (lane >> 3) + 8 * j; const float* s = scr + (8 * c) * 33 + n;
        v4u o; o.x = pk2(s[0 * 33], s[1 * 33]); o.y = pk2(s[2 * 33], s[3 * 33]); o.z = pk2(s[4 * 33], s[5 * 33]); o.w = pk2(s[6 * 33], s[7 * 33]);
        __builtin_nontemporal_store(o, (v4u*)(WT + (size_t)(drow0 + n) * K + k0 + 8 * c)); }
    asm volatile("s_waitcnt lgkmcnt(0)" ::: "memory");
}
__device__ __forceinline__ void st_weights(const int tid_, const Args& p, float* lds) {
    const int lane = tid_ & 63, w = tid_ >> 6, gw = blockIdx.x * NWAVES + w, ngw = gridDim.x * NWAVES;
    float* scr = lds + w * 4096;
    constexpr int I_SQ = 32 * 64;
    constexpr int I_MOE = 2 * NE * 3 * I_SQ;
    constexpr int I_IN0 = 32 * 128, I_IN1 = 32 * 256;
    constexpr int NITEMS = I_MOE + I_IN0 + I_SQ + I_IN1 + I_SQ;
    for (int it = gw; it < NITEMS; it += ngw) {
        int r = it;
        if (r < I_MOE) {
            const int mat = r / I_SQ, ii = r % I_SQ, l = mat / 48, e = (mat % 48) / 3, which = mat % 3;
            const int kb = ii / 64, nb = ii % 64, k0 = kb * 64, n0 = nb * 32;
            const size_t wo = ((size_t)l * NE + e) * D * D;
            if (which == 2) transpose_item(p.moe_w2 + wo, D, D, p.WdnT + wo, k0, n0, n0, scr, lane);
            else {
                const int drow0 = 256 * (n0 >> 7) + (n0 & 127) + (which ? 128 : 0);
                transpose_item((which ? p.moe_w3 : p.moe_w1) + wo, D, D, p.WupT + 2 * wo, k0, n0, drow0, scr, lane);
            }
            continue;
        }
        r -= I_MOE;
        if (r < I_IN0) { const int kb = r / 128, nb = r % 128; transpose_item(p.ab_w_in, D, 4096, p.WinT0, kb * 64, nb * 32, nb * 32, scr, lane); continue; }
        r -= I_IN0;
        if (r < I_SQ) { const int kb = r / 64, nb = r % 64; transpose_item(p.ab_w_out, D, D, p.WoutT0, kb * 64, nb * 32, nb * 32, scr, lane); continue; }
        r -= I_SQ;
        if (r < I_IN1) { const int kb = r / 256, nb = r % 256; transpose_item(p.cd_w_in, D, 8192, p.WinT1, kb * 64, nb * 32, nb * 32, scr, lane); continue; }
        r -= I_IN1;
        { const int kb = r / 64, nb = r % 64; transpose_item(p.cd_w_out, D, D, p.WoutT1, kb * 64, nb * 32, nb * 32, scr, lane); }
    }
}
__device__ __forceinline__ void st_init(const int tid_, const Args& p) {
    const size_t n4 = (size_t)T * D / 4, nl4 = (size_t)TL * D / 4;
    for (size_t i = (size_t)blockIdx.x * NT + tid_; i < n4; i += (size_t)gridDim.x * NT) {
        float4 v = i < nl4 ? ((const float4*)p.x)[i] : ((const float4*)p.ctx)[i - nl4];
        ((float4*)p.X)[i] = v;
    }
}
__device__ __forceinline__ void st_ada(const int tid_, const Args& p, float* lds) {
    const int tid = tid_, lane = tid & 63, w = tid >> 6;
    float* sl = lds;
    float* red = lds + 5 * D;
    __syncthreads();
    for (int i = tid; i < 5 * D; i += NT) { const int r = i >> 11, k = i & (D - 1); sl[i] = siluf_(r < 4 ? p.c[r * D + k] : p.c_ctx[k]); }
    __syncthreads();
    for (int u = blockIdx.x; u < 384; u += gridDim.x) {
        const int l = u / 192, j = (u % 192) * 64 + lane;
        const float* W = p.ada_w + (size_t)l * D * 12288 + j;
        float acc[5] = {0.f, 0.f, 0.f, 0.f, 0.f};
#pragma unroll 16
        for (int k = w * 256; k < (w + 1) * 256; ++k) {
            const float wv = __builtin_nontemporal_load(W + (size_t)k * 12288);
#pragma unroll
            for (int r = 0; r < 5; ++r) acc[r] += sl[r * D + k] * wv;
        }
        __syncthreads();
#pragma unroll
        for (int r = 0; r < 5; ++r) red[(w * 5 + r) * 64 + lane] = acc[r];
        __syncthreads();
        if (tid < 320) {
            const int r = tid >> 6;
            float sum = 0.f;
            for (int ww = 0; ww < 8; ++ww) sum += red[(ww * 5 + r) * 64 + lane];
            p.MOD[((size_t)l * 5 + r) * 12288 + j] = sum + p.ada_b[l * 12288 + j];
        }
    }
    __syncthreads();
}

__device__ __forceinline__ void st_norm_mod(const int tid_, const Args& p, int l, int nrows, int which = 0, int b0 = 0) {
    if ((int)blockIdx.x < b0) return;
    const int lane = tid_ & 63, gw = ((int)blockIdx.x - b0) * NWAVES + (tid_ >> 6), nw = ((int)gridDim.x - b0) * NWAVES;
    const float* g = p.norm_g + (size_t)(l * 2 + which) * D;
    const bool fromX = !(l == 0 && which == 0);
    const int rpw = (nrows + nw - 1) / nw, r_lo = gw * rpw, r_hi = (r_lo + rpw < nrows) ? r_lo + rpw : nrows;
    float4 A[8], B[8];
    int cur_m = -1;
    for (int row = r_lo; row < r_hi; ++row) {
        const int m = mod_row(row);
        if (m != cur_m) {
            cur_m = m;
            const float* md = p.MOD + ((size_t)l * 5 + m) * 12288 + (which ? 3 * D : 0);
#pragma unroll
            for (int i = 0; i < 8; ++i) {
                const int j = (lane + 64 * i) * 4;
                const float4 gg = *(const float4*)(g + j), sh = *(const float4*)(md + j), sc = *(const float4*)(md + D + j);
                A[i] = make_float4(gg.x * (1.f + sc.x), gg.y * (1.f + sc.y), gg.z * (1.f + sc.z), gg.w * (1.f + sc.w)); B[i] = sh;
            }
        }
        const float* xr = row < TL ? p.x + (size_t)row * D : p.ctx + (size_t)(row - TL) * D;
        float4 v[8];
        float ss = 0.f;
#pragma unroll
        for (int i = 0; i < 8; ++i) { v[i] = fromX ? ldx4((const bf16*)p.X + (size_t)row * D + (lane + 64 * i) * 4) : ((const float4*)xr)[lane + 64 * i]; ss += v[i].x * v[i].x + v[i].y * v[i].y + v[i].z * v[i].z + v[i].w * v[i].w; }
        ss = wave_sum(ss);
        const float rs = 1.0f / sqrtf(ss / D + EPS);
#pragma unroll
        for (int i = 0; i < 8; ++i) {
            const int j = (lane + 64 * i) * 4;
            v2u o;
            o.x = pk2(v[i].x * rs * A[i].x + B[i].x, v[i].y * rs * A[i].y + B[i].y);
            o.y = pk2(v[i].z * rs * A[i].z + B[i].z, v[i].w * rs * A[i].w + B[i].w);
            *(v2u*)(p.H + (size_t)row * D + j) = o;
        }
    }
}

__device__ __forceinline__ void st_l0_pre(const int tid_, const Args& p) {
    const size_t n = (size_t)T * 128;
#pragma unroll 2
    for (size_t idx = (size_t)blockIdx.x * NT + tid_; idx < n; idx += (size_t)gridDim.x * NT) {
        const size_t row = idx >> 7; const int c8 = (int)(idx & 127) * 8;
        const v4u a = *(const v4u*)(p.Z16 + row * 4096 + c8), gt = *(const v4u*)(p.Z16 + row * 4096 + 1024 + c8);
        const unsigned aw[4] = {a.x, a.y, a.z, a.w}, gw_[4] = {gt.x, gt.y, gt.z, gt.w};
        float o[8];
#pragma unroll
        for (int q = 0; q < 4; ++q) {
            const float a0 = __builtin_bit_cast(float, aw[q] << 16), a1 = __builtin_bit_cast(float, aw[q] & 0xffff0000u);
            const float g0 = __builtin_bit_cast(float, gw_[q] << 16), g1 = __builtin_bit_cast(float, gw_[q] & 0xffff0000u);
            o[2 * q] = a0 * __builtin_amdgcn_rcpf(1.0f + __expf(-g0)); o[2 * q + 1] = a1 * __builtin_amdgcn_rcpf(1.0f + __expf(-g1));
        }
        v4u u; u.x = cvtpk(o[0], o[1]); u.y = cvtpk(o[2], o[3]); u.z = cvtpk(o[4], o[5]); u.w = cvtpk(o[6], o[7]);
        *(v4u*)((bf16*)p.U + row * 1024 + c8) = u;
    }
}
template <int RR, int TT>
__device__ __forceinline__ void conf_row_steps(const Args& p, float (&v)[2][TT], const float (&wk)[2][31], int n0, int len, int row0, int c0) {
    if constexpr (RR < TT + 30) {
        const int m = n0 - 15 + RR;
        const bool inseq = (m >= 0 && m < len);
        const unsigned up = *(const unsigned*)((const bf16*)p.U + (size_t)(inseq ? row0 - 15 + RR : row0) * 1024 + c0);
        float2 uu; uu.x = inseq ? __builtin_bit_cast(float, up << 16) : 0.f; uu.y = inseq ? __builtin_bit_cast(float, up & 0xffff0000u) : 0.f;
#pragma unroll
        for (int k = 0; k < 31; ++k) {
            const int t = RR - k;
            if (t >= 0 && t < TT) { v[0][t] += wk[0][k] * uu.x; v[1][t] += wk[1][k] * uu.y; }
        }
        conf_row_steps<RR + 1, TT>(p, v, wk, n0, len, row0, c0);
    }
}
__device__ __forceinline__ void st_l0_conf(const int tid_, const Args& p, float* lds) {
    constexpr int TT = 16;
    const int tid = tid_, lane = tid & 63, w = tid >> 6, c0 = 2 * tid;
    float* part = lds;
    float* stat = lds + 256;
    float wk[2][31];
#pragma unroll
    for (int k = 0; k < 31; ++k) { const float2 ww = *(const float2*)(p.conf_dw_w + k * 1024 + c0); wk[0][k] = ww.x; wk[1][k] = ww.y; }
    const float2 bias = *(const float2*)(p.conf_dw_b + c0), gg = *(const float2*)(p.conf_ln_g + c0), bb = *(const float2*)(p.conf_ln_b + c0);
    for (int u = blockIdx.x; u < T / TT; u += gridDim.x) {
        const int row0 = u * TT;
        int n0, len; seq_pos(row0, n0, len);
        float v[2][TT];
#pragma unroll
        for (int t = 0; t < TT; ++t) { v[0][t] = bias.x; v[1][t] = bias.y; }
        conf_row_steps<0, TT>(p, v, wk, n0, len, row0, c0);
        float a[2 * TT];
#pragma unroll
        for (int t = 0; t < TT; ++t) { a[t] = v[0][t] + v[1][t]; a[TT + t] = v[0][t] * v[0][t] + v[1][t] * v[1][t]; }
#pragma unroll
        for (int st = 0; st < 5; ++st) {
            const int half = TT >> st;
            const int bit = 32 >> st;
            const bool up = (lane & bit) != 0;
#pragma unroll
            for (int i = 0; i < half; ++i) {
                const float send = up ? a[i] : a[i + half];
                const float keep = up ? a[i + half] : a[i];
                a[i] = keep + __shfl_xor(send, bit, 64);
            }
        }
        a[0] += __shfl_xor(a[0], 1, 64);
        __syncthreads();
        if ((lane & 1) == 0) part[w * 32 + (lane >> 1)] = a[0];
        __syncthreads();
        if (tid < 32) {
            float sum = 0.f;
#pragma unroll
            for (int ww = 0; ww < 8; ++ww) sum += part[ww * 32 + tid];
            stat[tid] = sum;
        }
        __syncthreads();
#pragma unroll
        for (int t = 0; t < TT; ++t) {
            const float mu = stat[t] * (1.0f / 1024.0f);
            const float var = stat[TT + t] * (1.0f / 1024.0f) - mu * mu;
            const float rs = 1.0f / sqrtf(fmaxf(var, 0.f) + EPS);
            const float y0 = (v[0][t] - mu) * rs * gg.x + bb.x, y1 = (v[1][t] - mu) * rs * gg.y + bb.y;
            *(unsigned*)(p.CAT + (size_t)(row0 + t) * D + c0) = pk2(siluf_(y0), siluf_(y1));
        }
    }
    __syncthreads();
}
template <int DIR>
__device__ __forceinline__ void lru_epilogue(const Args& p, const f32x4_t (&pa)[4], const f32x4_t (&pi)[4], const float* xs, float bav, float biv, float spv,
                                             int li, int g, int jt, int h, int rt, int row0) {
    constexpr int dir = DIR;
        const int cj = 16 * jt + li, ch = h * 64 + cj;
        float pl[4][4], hl[4][4], segP[4], segH[4];
#pragma unroll
        for (int tt = 0; tt < 4; ++tt) {
            float av[4], bv[4];
#pragma unroll
            for (int e = 0; e < 4; ++e) {
                const float rr = sigmoidf_(pa[tt][e] + bav), ig = sigmoidf_(pi[tt][e] + biv);
                const float log_a = -8.0f * rr * spv;
                av[e] = __expf(log_a);
                const float x2 = 2.0f * log_a;
                const float em_s = -x2 * (1.0f + x2 * (0.5f + x2 * (0.16666667f + x2 * (0.041666668f + x2 * 0.0083333333f))));
                const float em = x2 > -0.1f ? em_s : 1.0f - __expf(x2);
                bv[e] = __builtin_amdgcn_sqrtf(em) * (ig * xs[(16 * tt + 4 * g + e) * 64 + cj]);
            }
            float P = 1.f, hh = 0.f;
#pragma unroll
            for (int q = 0; q < 4; ++q) { const int e = dir ? 3 - q : q; hh = av[e] * hh + bv[e]; P *= av[e]; hl[tt][e] = hh; pl[tt][e] = P; }
            segP[tt] = P; segH[tt] = hh;
        }
        float cP[4], cH[4];
        {
            float rP = 1.f, rH = 0.f;
#pragma unroll
            for (int q = 0; q < 16; ++q) {
                const int qq = dir ? 15 - q : q, tt = qq >> 2, gg = qq & 3;
                const float Pq = __shfl(segP[tt], li + 16 * gg, 64), Hq = __shfl(segH[tt], li + 16 * gg, 64);
                if (gg == g) { cP[tt] = rP; cH[tt] = rH; }
                rH = Pq * rH + Hq; rP *= Pq;
            }
        }
        unsigned* ABo = (unsigned*)(dir ? p.AB : p.AF);
#pragma unroll
        for (int tt = 0; tt < 4; ++tt)
#pragma unroll
            for (int e = 0; e < 4; ++e) {
                const int tok = 16 * tt + 4 * g + e;
                const size_t o = (size_t)(row0 + tok) * 1024 + ch;
                const float pc = pl[tt][e] * cP[tt], hloc = hl[tt][e] + pl[tt][e] * cH[tt];
                ABo[o] = cvtpk(pc, hloc);
                const bool last = dir ? (tok == 0) : (tok == 63);
                if (last) { p.TSP[((size_t)rt * 2 + dir) * 1024 + ch] = pc; p.TSH[((size_t)rt * 2 + dir) * 1024 + ch] = hloc; }
            }
}
__device__ __forceinline__ void st_l0_lru(const int tid_, const Args& p, float* lds) {
    const int tid = tid_, lane = tid & 63, w = __builtin_amdgcn_readfirstlane(tid >> 6), li = lane & 15, g = lane >> 4, j = tid & 63;
    const int dir = w >> 2, jt = w & 3;
    float* xs = lds;
    bf16* xsb = (bf16*)(lds + 4096);
    bf16* WT = (bf16*)(lds + 4096 + 2304);
    bf16* raw = (bf16*)(lds + 4096 + 2304 + 9216);
    const int nunits = (T / 64) * 16;
    int cur_h = -1;
    v4u raw0 = {0u, 0u, 0u, 0u}, raw1 = {0u, 0u, 0u, 0u}; bool have_raw = false;
    float cwv[4] = {0.f, 0.f, 0.f, 0.f}, cbv = 0.f, bav = 0.f, biv = 0.f, spv = 0.f;
    bf16x8_t wf[2][2];
    wf[0][0] = wf[0][1] = wf[1][0] = wf[1][1] = (bf16x8_t){0, 0, 0, 0, 0, 0, 0, 0};
#define LRU_FETCH(uu) do { const int h_ = (uu) & 15, row0_ = ((uu) >> 4) * 64; int n0_, len_; seq_pos(row0_, n0_, len_); \
        { const int r_ = tid >> 3, m_ = n0_ + r_ - 2; raw0 = (v4u){0u, 0u, 0u, 0u}; if (m_ >= 0 && m_ < len_) raw0 = *(const v4u*)(p.Z16 + (size_t)(row0_ + r_ - 2) * 4096 + 3072 + h_ * 64 + (tid & 7) * 8); } \
        if (tid < 24) { const int r_ = 64 + (tid >> 3), m_ = n0_ + r_ - 2; raw1 = (v4u){0u, 0u, 0u, 0u}; if (m_ >= 0 && m_ < len_) raw1 = *(const v4u*)(p.Z16 + (size_t)(row0_ + r_ - 2) * 4096 + 3072 + h_ * 64 + (tid & 7) * 8); } } while (0)
    for (int u = blockIdx.x; u < nunits; u += gridDim.x) {
        const int h = u & 15, rt = u >> 4, row0 = rt * 64;
        __syncthreads();
        if (h != cur_h) {
            for (int i = tid; i < 16384; i += NT) {
                const int s = i >> 12, o = i & 4095, d_ = s >> 1, ii = o >> 6, jj = o & 63;
                const float* src = (s & 1) ? p.lru_wi : p.lru_wa;
                WT[(s * 64 + jj) * 72 + ii] = (bf16)f2bf(src[(size_t)d_ * 16 * 4096 + h * 4096 + o]);
            }
            cur_h = h;
            const int chh = h * 64 + j;
#pragma unroll
            for (int k = 0; k < 4; ++k) cwv[k] = p.lru_conv_w[k * 1024 + chh];
            cbv = p.lru_conv_b[chh];
            const int che = h * 64 + 16 * jt + li;
            bav = p.lru_ba[dir * 1024 + che]; biv = p.lru_bi[dir * 1024 + che]; spv = log1pf(expf(-p.lru_lam[dir * 1024 + che]));
            __syncthreads();
#pragma unroll
            for (int s2 = 0; s2 < 2; ++s2)
#pragma unroll
                for (int ks = 0; ks < 2; ++ks) wf[s2][ks] = *(const bf16x8_t*)(WT + ((2 * dir + s2) * 64 + 16 * jt + li) * 72 + 32 * ks + 8 * g);
        }
        if (!have_raw) { LRU_FETCH(u); }
        {
            v4u* rt16 = (v4u*)raw;
            rt16[tid] = raw0; if (tid < 24) rt16[512 + tid] = raw1;
        }
        __syncthreads();
        { const int un = u + (int)gridDim.x; have_raw = un < nunits; if (have_raw) { LRU_FETCH(un); } }
        for (int i = tid; i < 4096; i += NT) {
            const int r = i >> 6, c = i & 63;
            float acc = cbv;
#pragma unroll
            for (int k = 0; k < 4; ++k) acc += cwv[k] * bf2f(raw[(r + k) * 64 + c]);
            xs[i] = acc;
            xsb[r * 72 + c] = (bf16)f2bf(acc);
        }
        __syncthreads();
        f32x4_t pa[4], pi[4];
#pragma unroll
        for (int tt = 0; tt < 4; ++tt) { pa[tt] = (f32x4_t){0.f, 0.f, 0.f, 0.f}; pi[tt] = (f32x4_t){0.f, 0.f, 0.f, 0.f}; }
#pragma unroll
        for (int tt = 0; tt < 4; ++tt)
#pragma unroll
            for (int ks = 0; ks < 2; ++ks) {
                const bf16x8_t xf = *(const bf16x8_t*)(xsb + (16 * tt + li) * 72 + 32 * ks + 8 * g);
                pa[tt] = __builtin_amdgcn_mfma_f32_16x16x32_bf16(xf, wf[0][ks], pa[tt], 0, 0, 0);
                pi[tt] = __builtin_amdgcn_mfma_f32_16x16x32_bf16(xf, wf[1][ks], pi[tt], 0, 0, 0);
            }
        if (dir) lru_epilogue<1>(p, pa, pi, xs, bav, biv, spv, li, g, jt, h, rt, row0); else lru_epilogue<0>(p, pa, pi, xs, bav, biv, spv, li, g, jt, h, rt, row0);
    }
    __syncthreads();
}
#undef LRU_FETCH
__device__ __forceinline__ void st_l0_carry(const int tid_, const Args& p) {
    const int tid = tid_;
    if (tid < 32) {
        for (int idx = blockIdx.x * 32 + tid; idx < 8192; idx += gridDim.x * 32) {
            const int ch = idx & 1023, b = (idx >> 10) & 3, dir = idx >> 12;
            float c = 0.f;
#pragma unroll 4
            for (int k = 0; k < 68; ++k) {
                int rt;
                if (dir == 0) rt = k < 4 ? (TL / 64 + b * 4 + k) : (b * 64 + (k - 4));
                else rt = k < 4 ? (TL / 64 + b * 4 + 3 - k) : (b * 64 + 63 - (k - 4));
                const size_t o = ((size_t)rt * 2 + dir) * 1024 + ch;
                p.CIN[o] = c;
                c = p.TSP[o] * c + p.TSH[o];
            }
        }
    }
}
__device__ __forceinline__ float gelu_tanh(float v) {
    const float u = 0.7978845608028654f * (v + 0.044715f * v * v * v);
    return v * __builtin_amdgcn_rcpf(1.0f + __expf(-2.0f * u));
}
__device__ __forceinline__ void st_l0_cat(const int tid_, const Args& p) {
    const size_t n = (size_t)T * 256;
#pragma unroll 2
    for (size_t idx = (size_t)blockIdx.x * NT + tid_; idx < n; idx += (size_t)gridDim.x * NT) {
        const size_t row = idx >> 8; const int c4 = (int)(idx & 255) * 4; const size_t rt = row >> 6;
        const v2u zy = *(const v2u*)(p.Z16 + row * 4096 + 2048 + c4);
        const float4 cf = *(const float4*)(p.CIN + (rt * 2 + 0) * 1024 + c4), cb = *(const float4*)(p.CIN + (rt * 2 + 1) * 1024 + c4);
        const size_t o = row * 1024 + c4;
        const v4u pf = *(const v4u*)((const unsigned*)p.AF + o), pb = *(const v4u*)((const unsigned*)p.AB + o);
        float4 af, bf, ab, bb;
        af.x = __builtin_bit_cast(float, pf.x << 16); bf.x = __builtin_bit_cast(float, pf.x & 0xffff0000u); af.y = __builtin_bit_cast(float, pf.y << 16); bf.y = __builtin_bit_cast(float, pf.y & 0xffff0000u);
        af.z = __builtin_bit_cast(float, pf.z << 16); bf.z = __builtin_bit_cast(float, pf.z & 0xffff0000u); af.w = __builtin_bit_cast(float, pf.w << 16); bf.w = __builtin_bit_cast(float, pf.w & 0xffff0000u);
        ab.x = __builtin_bit_cast(float, pb.x << 16); bb.x = __builtin_bit_cast(float, pb.x & 0xffff0000u); ab.y = __builtin_bit_cast(float, pb.y << 16); bb.y = __builtin_bit_cast(float, pb.y & 0xffff0000u);
        ab.z = __builtin_bit_cast(float, pb.z << 16); bb.z = __builtin_bit_cast(float, pb.z & 0xffff0000u); ab.w = __builtin_bit_cast(float, pb.w << 16); bb.w = __builtin_bit_cast(float, pb.w & 0xffff0000u);
        const float z0 = __builtin_bit_cast(float, zy.x << 16), z1 = __builtin_bit_cast(float, zy.x & 0xffff0000u), z2 = __builtin_bit_cast(float, zy.y << 16), z3 = __builtin_bit_cast(float, zy.y & 0xffff0000u);
        v2u r;
        r.x = pk2(gelu_tanh(z0) * (bf.x + af.x * cf.x + bb.x + ab.x * cb.x), gelu_tanh(z1) * (bf.y + af.y * cf.y + bb.y + ab.y * cb.y));
        r.y = pk2(gelu_tanh(z2) * (bf.z + af.z * cf.z + bb.z + ab.z * cb.z), gelu_tanh(z3) * (bf.w + af.w * cf.w + bb.w + ab.w * cb.w));
        *(v2u*)(p.CAT + row * D + 1024 + c4) = r;
    }
}

__device__ __forceinline__ void st_router_prep(const int tid_, const Args& p) {
    const int gt = blockIdx.x * NT + tid_, ngt = gridDim.x * NT;
    for (int i = gt; i < 2 * 5 * D; i += ngt) {
        const int j = i & (D - 1), m = (i >> 11) % 5, l = i / (5 * D);
        const float* md = p.MOD + ((size_t)l * 5 + m) * 12288;
        const float f = p.norm_g[(size_t)(l * 2 + 1) * D + j] * (1.0f + md[4 * D + j]);
        const float* r = p.moe_router + ((size_t)l * D + j) * NE;
#pragma unroll
        for (int e = 0; e < NE; ++e) {
            const float v = f * r[e];
            const unsigned hi = f2bf(v);
            const unsigned lo = f2bf(v - __builtin_bit_cast(float, hi << 16));
            const size_t o = (((size_t)l * 5 + m) * NE + e) * D + j;
            p.RTH[o] = (bf16)hi; p.RTL[o] = (bf16)lo;
        }
    }
    const int lane = tid_ & 63, gw = blockIdx.x * NWAVES + (tid_ >> 6), nw = gridDim.x * NWAVES;
    for (int u = gw; u < 2 * 5 * NE; u += nw) {
        const int e = u & 15, m = (u >> 4) % 5, l = u / 80;
        const float* md = p.MOD + ((size_t)l * 5 + m) * 12288 + 3 * D;
        float acc = 0.f;
        for (int j = lane; j < D; j += 64) acc += md[j] * p.moe_router[((size_t)l * D + j) * NE + e];
        acc = wave_sum(acc);
        if (lane == 0) p.RBIAS[u] = acc;
    }
}
__device__ __forceinline__ void st_post_mixer(const int tid_, const Args& p, int l, int nrows, float* lds) {
    const int lane = tid_ & 63, li = lane & 15, g = lane >> 4, w = __builtin_amdgcn_readfirstlane(tid_ >> 6), pair = w >> 1, kh = w & 1;
    const int npairs = gridDim.x * 4, pairid = blockIdx.x * 4 + pair, ntile = nrows / 16, nit = (ntile + npairs - 1) / npairs;
    float* ex = lds + pair * 320 + lane * 5;
    for (int it = 0; it < nit; ++it) {
        const int tile_ = it * npairs + pairid; const bool act = tile_ < ntile;
        const int tile = act ? tile_ : 0;
        const int row0 = tile * 16, m = mod_row(row0);
        const bf16* xr = (const bf16*)p.X + (size_t)(row0 + li) * D + 8 * g + kh * 1024;
        const bf16* rh = p.RTH + (((size_t)l * 5 + m) * NE + li) * D + 8 * g + kh * 1024;
        const bf16* rl = p.RTL + (((size_t)l * 5 + m) * NE + li) * D + 8 * g + kh * 1024;
        f32x4_t acc0 = (f32x4_t){0.f, 0.f, 0.f, 0.f}, acc1 = acc0;
        float ss = 0.f;
#pragma unroll 4
        for (int ks = 0; ks < 32; ++ks) {
            const v4u xw = *(const v4u*)(xr + 32 * ks);
            const bf16x8_t bh = *(const bf16x8_t*)(rh + 32 * ks), bl = *(const bf16x8_t*)(rl + 32 * ks);
            const unsigned xq[4] = {xw.x, xw.y, xw.z, xw.w};
#pragma unroll
            for (int q = 0; q < 4; ++q) { const float x0 = __builtin_bit_cast(float, xq[q] << 16), x1 = __builtin_bit_cast(float, xq[q] & 0xffff0000u); ss += x0 * x0 + x1 * x1; }
            const bf16x8_t ah = __builtin_bit_cast(bf16x8_t, xw);
            acc0 = __builtin_amdgcn_mfma_f32_16x16x32_bf16(ah, bh, acc0, 0, 0, 0);
            acc1 = __builtin_amdgcn_mfma_f32_16x16x32_bf16(ah, bl, acc1, 0, 0, 0);
        }
        ss += __shfl_xor(ss, 16, 64); ss += __shfl_xor(ss, 32, 64);
        f32x4_t a = acc0 + acc1;
        if (kh) { ex[0] = a[0]; ex[1] = a[1]; ex[2] = a[2]; ex[3] = a[3]; ex[4] = ss; }
        __syncthreads();
        if (!kh && act) {
            a[0] += ex[0]; a[1] += ex[1]; a[2] += ex[2]; a[3] += ex[3]; ss += ex[4];
            const float rs = 1.0f / sqrtf(ss / D + EPS);
            const float bias = p.RBIAS[(l * 5 + m) * NE + li];
            float lg[4];
#pragma unroll
            for (int i = 0; i < 4; ++i) lg[i] = a[i] * __shfl(rs, 4 * g + i, 64) + bias;
#pragma unroll
            for (int i = 0; i < 4; ++i) {
                float mx = lg[i];
#pragma unroll
                for (int o = 8; o >= 1; o >>= 1) mx = fmaxf(mx, __shfl_xor(mx, o, 64));
                const float ev = expf(lg[i] - mx);
                float sum = ev;
#pragma unroll
                for (int o = 8; o >= 1; o >>= 1) sum += __shfl_xor(sum, o, 64);
                const size_t o = (size_t)(row0 + 4 * g + i) * NE + li;
                p.AFF[o] = ev / sum; p.SLOTOF[o] = -1;
            }
        }
        __syncthreads();
    }
}

template <int N, int CAP>
__device__ __forceinline__ void topk_sort_set(const int tid, const Args& p, unsigned long long* keys, int e, int row_base, int slot_base) {
    __syncthreads();
    for (int i = tid; i < N; i += NT) keys[i] = ((unsigned long long)__float_as_uint(p.AFF[(size_t)(row_base + i) * NE + e]) << 32) | (unsigned)(N - 1 - i);
    __syncthreads();
    for (int k = 2; k <= N; k <<= 1) {
        for (int j = k >> 1; j > 0; j >>= 1) {
            for (int t = tid; t < N / 2; t += NT) {
                const int i = ((t & ~(j - 1)) << 1) | (t & (j - 1)), l = i | j;
                const unsigned long long x = keys[i], y = keys[l];
                const bool desc = (i & k) == 0;
                if ((x < y) == desc) { keys[i] = y; keys[l] = x; }
            }
            __syncthreads();
        }
    }
    for (int i = tid; i < CAP; i += NT) {
        const unsigned long long key = keys[i];
        const int row = row_base + (N - 1 - (int)(unsigned)(key & 0xffffffffu)), slot = slot_base + i;
        p.LIST[e * ME + slot] = row; p.GATEV[e * ME + slot] = __uint_as_float((unsigned)(key >> 32)); p.SLOTOF[(size_t)row * NE + e] = slot;
    }
}
__device__ __forceinline__ void st_topk(const int tid_, const Args& p, bool with_ctx, float* lds) {
    unsigned long long* keys = (unsigned long long*)lds;
    const int nunits = with_ctx ? 128 : 64;
    for (int u = blockIdx.x; u < nunits; u += gridDim.x) {
        const int e = u & 15, b = (u >> 4) & 3;
        if (u < 64) topk_sort_set<SEQ, 512>(tid_, p, keys, e, b * SEQ, b * 512);
        else topk_sort_set<CTXL, 32>(tid_, p, keys, e, TL + b * CTXL, 2048 + b * 32);
    }
    __syncthreads();
}

__device__ __forceinline__ void st_gather(const int tid_, const Args& p, int nslots, int npad) {
    const int lane = tid_ & 63, gw = blockIdx.x * NWAVES + (tid_ >> 6), nw = gridDim.x * NWAVES;
    for (int u4 = gw; u4 < NE * npad / 4; u4 += nw) {
        const int u = u4 * 4, e = u / npad, slot0 = u % npad;
        int rows[4];
#pragma unroll
        for (int k = 0; k < 4; ++k) rows[k] = (slot0 + k < nslots) ? p.LIST[e * ME + slot0 + k] : -1;
        v4u v[4][4];
#pragma unroll
        for (int k = 0; k < 4; ++k) {
            const v4u* src = (const v4u*)(p.H + (size_t)(rows[k] < 0 ? 0 : rows[k]) * D);
#pragma unroll
            for (int i = 0; i < 4; ++i) v[k][i] = src[lane + 64 * i];
        }
#pragma unroll
        for (int k = 0; k < 4; ++k) {
            v4u* dst = (v4u*)(p.XS + ((size_t)e * MEP + slot0 + k) * D);
            const v4u z = {0u, 0u, 0u, 0u};
#pragma unroll
            for (int i = 0; i < 4; ++i) dst[lane + 64 * i] = rows[k] < 0 ? z : v[k][i];
        }
    }
}

template <bool FINAL>
__device__ __forceinline__ void st_combine(const int tid_, const Args& p, int l, int nrows) {
    const int lane = tid_ & 63, gw = blockIdx.x * NWAVES + (tid_ >> 6), nw = gridDim.x * NWAVES;
    const int rpw = (nrows + nw - 1) / nw, r_lo = gw * rpw, r_hi = (r_lo + rpw < nrows) ? r_lo + rpw : nrows;
    int slot_n = -1; float gate_n = 0.f;
    if (r_lo < r_hi && lane < NE) { slot_n = p.SLOTOF[(size_t)r_lo * NE + lane]; if (slot_n >= 0) gate_n = p.GATEV[lane * ME + slot_n]; }
    for (int row = r_lo; row < r_hi; ++row) {
        const int slot_v = slot_n; const float gate_v = gate_n;
        slot_n = -1; gate_n = 0.f;
        if (row + 1 < r_hi && lane < NE) { slot_n = p.SLOTOF[(size_t)(row + 1) * NE + lane]; if (slot_n >= 0) gate_n = p.GATEV[lane * ME + slot_n]; }
        const float* md = p.MOD + ((size_t)l * 5 + mod_row(row)) * 12288 + 5 * D;
        float4 acc[8];
#pragma unroll
        for (int i = 0; i < 8; ++i) acc[i] = make_float4(0.f, 0.f, 0.f, 0.f);
        unsigned long long mask = __ballot(slot_v >= 0);
        while (mask) {
            const int e = __builtin_ctzll(mask); mask &= mask - 1;
            const int slot = __builtin_amdgcn_readlane(slot_v, e);
            const float gt = __builtin_bit_cast(float, __builtin_amdgcn_readlane(__builtin_bit_cast(int, gate_v), e));
            const v2u* y = (const v2u*)(p.Y16 + ((size_t)e * MEP + slot) * D);
#pragma unroll
            for (int i = 0; i < 8; ++i) { const v2u yv = y[lane + 64 * i];
                acc[i].x += gt * __builtin_bit_cast(float, yv.x << 16); acc[i].y += gt * __builtin_bit_cast(float, yv.x & 0xffff0000u);
                acc[i].z += gt * __builtin_bit_cast(float, yv.y << 16); acc[i].w += gt * __builtin_bit_cast(float, yv.y & 0xffff0000u); }
        }
        bf16* xr = (bf16*)p.X + (size_t)row * D;
        float ss = 0.f;
#pragma unroll
        for (int i = 0; i < 8; ++i) {
            const float4 m = ((const float4*)md)[lane + 64 * i];
            float4 xv = ldx4(xr + (lane + 64 * i) * 4);
            xv.x += m.x * acc[i].x; xv.y += m.y * acc[i].y; xv.z += m.z * acc[i].z; xv.w += m.w * acc[i].w;
            if (FINAL) { acc[i] = xv; ss += xv.x * xv.x + xv.y * xv.y + xv.z * xv.z + xv.w * xv.w; }
            else stx4(xr + (lane + 64 * i) * 4, xv);
        }
        if (FINAL) {
            ss = wave_sum(ss);
            const float rs = 1.0f / sqrtf(ss / D + EPS);
#pragma unroll
            for (int i = 0; i < 8; ++i) {
                const float4 gg = ((const float4*)p.final_g)[lane + 64 * i];
                ((float4*)(p.out + (size_t)row * D))[lane + 64 * i] = make_float4(acc[i].x * rs * gg.x, acc[i].y * rs * gg.y, acc[i].z * rs * gg.z, acc[i].w * rs * gg.w);
            }
        }
    }
}

__device__ __forceinline__ void st_vt(const int tid_, const Args& p, float* lds, const int colgrp, bf16* dstT) {
    bf16* tile = (bf16*)lds;
    const int tid = tid_;
    for (int u = blockIdx.x; u < (T / 64) * 8; u += gridDim.x) {
        const int h = u & 7, rt = u >> 3, row0 = rt * 64;
        int b, key0;
        if (row0 < TL) { b = row0 >> 12; key0 = row0 & 4095; } else { b = (row0 - TL) >> 8; key0 = 4096 + ((row0 - TL) & 255); }
        __syncthreads();
        for (int i = tid; i < 1024; i += NT) {
            const int tok = i >> 4, c = i & 15;
            const v4u v = *(const v4u*)(p.Z16 + (size_t)(row0 + tok) * 8192 + colgrp * 1024 + h * 128 + c * 8);
            const unsigned wv[4] = {v.x, v.y, v.z, v.w};
#pragma unroll
            for (int q = 0; q < 4; ++q) { tile[(c * 8 + 2 * q) * 72 + tok] = (bf16)(wv[q] & 0xffffu); tile[(c * 8 + 2 * q + 1) * 72 + tok] = (bf16)(wv[q] >> 16); }
        }
        __syncthreads();
        for (int i = tid; i < 1024; i += NT) {
            const int d = i >> 3, c = i & 7;
            const v4u v = *(const v4u*)(tile + d * 72 + c * 8);
            *(v4u*)(dstT + (((size_t)(b * 8 + h) * 272 + (key0 >> 4) + (c >> 1)) * 128 + d) * 16 + (c & 1) * 8) = v;
        }
    }
    __syncthreads();
}
__device__ __forceinline__ float na_sel(int negbits, float x, int mbits, int bit) { const int m = (mbits << (31 - bit)) >> 31; return __builtin_bit_cast(float, (__builtin_bit_cast(int, x) & m) | (negbits & ~m)); }
__device__ __forceinline__ void st_na(const int tid_, const Args& p, float* lds) {
    const int tid = tid_, lane = tid & 63, w = __builtin_amdgcn_readfirstlane(tid >> 6), li = lane & 15, g = lane >> 4;
    const float scale2 = 0.08838834764831845f * 1.4426950408889634f;
    const int negbits = __builtin_bit_cast(int, -1.0e30f);
    const int half = w & 1, rq = w >> 1, q0col = half * 32, ct0 = half;
    int mbits = 0;
#pragma unroll
    for (int C = 0; C < 3; ++C)
#pragma unroll
        for (int qt = 0; qt < 2; ++qt) {
            const int qcol = q0col + 16 * qt + li; int c0q = qcol - 8; c0q = c0q < 0 ? 0 : (c0q > 48 ? 48 : c0q);
#pragma unroll
            for (int i = 0; i < 4; ++i) { const int kcol = 16 * (ct0 + C) + 4 * g + i; mbits |= ((kcol >= c0q) && (kcol < c0q + 16)) ? (1 << (8 * C + 4 * qt + i)) : 0; }
        }
    const bf16* Zb = p.Z16;
    const unsigned tlane = (unsigned)(4 * g - li + 18) * 16u;
    bf16* KL = (bf16*)((char*)lds + 24576);
    bf16* VL = KL + 2 * 64 * 136;
    const unsigned stlane = (unsigned)((tid >> 3) * 8192 + (tid & 7) * 8) * 2u;
    const unsigned kfrag = (unsigned)(li * 136 + 8 * g) * 2u, vfrag = (unsigned)(li * 16 + 4 * g) * 2u;
    for (int U = blockIdx.x; U < 512; U += gridDim.x) {
        const int b = U >> 7, h = (U >> 4) & 7, R = (U & 15) * 4;
        const int r = R + rq;
        int r0 = r - 4; r0 = r0 < 0 ? 0 : (r0 > 56 ? 56 : r0);
        int rho0 = R - 4; rho0 = rho0 < 0 ? 0 : (rho0 > 56 ? 56 : rho0);
        int rho1 = R - 1; rho1 = (rho1 < 0 ? 0 : (rho1 > 56 ? 56 : rho1)) + 7;
        const int nsteps = 4 + (rho1 - rho0 + 1);
        __syncthreads();
        for (int i = fresh_tid(w); i < 15 * 92; i += NT) {
            const int dr = i / 92, k = i - dr * 92 - 29;
            f32x4_t e;
#pragma unroll
            for (int ii = 0; ii < 4; ++ii) { const int d = k - 3 + ii; const int dcl = d < 0 ? 0 : (d > 30 ? 30 : d); const float v = p.na_bias[(h * 15 + dr) * 31 + dcl] * 1.4426950408889634f; e[ii] = (d >= 0 && d <= 30) ? v : 0.f; }
            *(f32x4_t*)(lds + i * 4) = e;
        }
        bf16x8_t Qf[2][4];
#pragma unroll
        for (int qt = 0; qt < 2; ++qt) {
            const unsigned qo = (unsigned)((b * SEQ + r * 64 + q0col + 16 * qt + li) * 8192 + h * 128 + 8 * g) * 2u;
#pragma unroll
            for (int ds = 0; ds < 4; ++ds) Qf[qt][ds] = *(const bf16x8_t*)((const char*)Zb + qo + 64 * ds);
        }
        f32x4_t O[8][2];
#pragma unroll
        for (int dt = 0; dt < 8; ++dt) { O[dt][0] = (f32x4_t){0.f, 0.f, 0.f, 0.f}; O[dt][1] = (f32x4_t){0.f, 0.f, 0.f, 0.f}; }
        float lsum[2] = {0.f, 0.f}, mref[2] = {0.f, 0.f};
        const bf16* VTg = p.VT + (size_t)(b * 8 + h) * 272 * 2048;
        const char* tabu = (const char*)lds + (29 - 16 * half) * 16 - 256;
        v4u skA0, skA1, svA0, svA1, skB0, skB1, svB0, svB1;
#define NA_FETCH(s_, sk0, sk1, sv0, sv1) do { const int s__ = (s_); int krow_, kt_; \
            if (s__ < 4) { krow_ = TL + b * CTXL + 64 * s__; kt_ = 256 + 4 * s__; } else { const int rho_ = rho0 + s__ - 4; krow_ = b * SEQ + rho_ * 64; kt_ = rho_ * 4; } \
            unsigned so_ = stlane; asm volatile("" : "+v"(so_));        \
            const char* ks_ = (const char*)Zb + ((size_t)krow_ * 8192 + 1024 + h * 128) * 2; \
            sk0 = *(const v4u*)(ks_ + so_); sk1 = *(const v4u*)(ks_ + so_ + 128); \
            unsigned vo_ = (unsigned)tid * 16u; asm volatile("" : "+v"(vo_)); \
            const char* vs_ = (const char*)VTg + (size_t)kt_ * 4096; sv0 = *(const v4u*)(vs_ + vo_); sv1 = *(const v4u*)(vs_ + vo_ + 8192); } while (0)
#define NA_PUT(buf_, sk0, sk1, sv0, sv1) do { bf16* kd_ = KL + (buf_) * 64 * 136 + (tid >> 3) * 136 + (tid & 7) * 8; *(v4u*)kd_ = sk0; *(v4u*)(kd_ + 64) = sk1; \
            v4u* vd_ = (v4u*)(VL + (buf_) * 8192); vd_[tid] = sv0; vd_[tid + 512] = sv1; } while (0)
#define NA_TILES(buf_, t0_, t1_, KIND_, drow_, first_) do { \
            const char* kb_ = (const char*)KL + (buf_) * (64 * 136 * 2) + kfrag; const char* vb_ = (const char*)VL + (buf_) * 16384 + vfrag; \
            f32x4_t S[2][2]; \
            _Pragma("unroll") for (int t = 0; t < 2; ++t) { S[t][0] = (f32x4_t){0.f, 0.f, 0.f, 0.f}; S[t][1] = (f32x4_t){0.f, 0.f, 0.f, 0.f}; } \
            _Pragma("unroll") for (int t = 0; t < ((KIND_) == 2 ? 1 : 2); ++t) { const int tl_ = t ? (t1_) : (t0_); \
                _Pragma("unroll") for (int ds = 0; ds < 4; ++ds) { const bf16x8_t kf = *(const bf16x8_t*)(kb_ + tl_ * (16 * 136 * 2) + 64 * ds); \
                    S[t][0] = __builtin_amdgcn_mfma_f32_16x16x32_bf16(kf, Qf[0][ds], S[t][0], 0, 0, 0); \
                    S[t][1] = __builtin_amdgcn_mfma_f32_16x16x32_bf16(kf, Qf[1][ds], S[t][1], 0, 0, 0); } } \
            float pv[2][2][4]; \
            if ((KIND_) != 0) { const char* tb_ = tabu + (drow_) * 1472 + tlane; int mb_ = mbits; asm volatile("" : "+v"(mb_));     \
                _Pragma("unroll") for (int t = 0; t < ((KIND_) == 2 ? 1 : 2); ++t) _Pragma("unroll") for (int qt = 0; qt < 2; ++qt) { const int C_ = (KIND_) == 2 ? 2 : t; \
                    const f32x4_t bias_ = *(const f32x4_t*)(tb_ + (C_ - qt + 1) * 256); \
                    _Pragma("unroll") for (int i = 0; i < 4; ++i) pv[t][qt][i] = na_sel(negbits, __builtin_fmaf(S[t][qt][i], scale2, bias_[i]), mb_, 8 * C_ + 4 * qt + i); } } \
            else { _Pragma("unroll") for (int t = 0; t < 2; ++t) _Pragma("unroll") for (int qt = 0; qt < 2; ++qt) _Pragma("unroll") for (int i = 0; i < 4; ++i) pv[t][qt][i] = S[t][qt][i] * scale2; } \
            if ((KIND_) == 0 && (first_)) { _Pragma("unroll") for (int qt = 0; qt < 2; ++qt) { float mx = -3.0e38f; \
                _Pragma("unroll") for (int t = 0; t < 2; ++t) _Pragma("unroll") for (int i = 0; i < 4; ++i) mx = fmaxf(mx, pv[t][qt][i]); \
                mx = fmaxf(mx, __shfl_xor(mx, 16, 64)); mx = fmaxf(mx, __shfl_xor(mx, 32, 64)); mref[qt] = mx; } } \
            bf16x8_t Pf[2]; \
            _Pragma("unroll") for (int qt = 0; qt < 2; ++qt) { float e[8]; \
                _Pragma("unroll") for (int t = 0; t < 2; ++t) _Pragma("unroll") for (int i = 0; i < 4; ++i) { \
                    if ((KIND_) == 2 && t == 1) e[t * 4 + i] = 0.f; \
                    else { const float ev = __builtin_amdgcn_exp2f(pv[t][qt][i] - mref[qt]); e[t * 4 + i] = ev; lsum[qt] += ev; } } \
                v4u pk; pk.x = cvtpk(e[0], e[1]); pk.y = cvtpk(e[2], e[3]); pk.z = cvtpk(e[4], e[5]); pk.w = cvtpk(e[6], e[7]); \
                Pf[qt] = __builtin_bit_cast(bf16x8_t, pk); } \
            const int t1c_ = (KIND_) == 2 ? (t0_) : (t1_); \
            _Pragma("unroll") for (int dt = 0; dt < 8; ++dt) { \
                const v2u lo_ = *(const v2u*)(vb_ + (t0_) * 4096 + dt * 512), hi_ = *(const v2u*)(vb_ + t1c_ * 4096 + dt * 512); \
                v4u vv; vv.x = lo_.x; vv.y = lo_.y; vv.z = hi_.x; vv.w = hi_.y; \
                const bf16x8_t vf = __builtin_bit_cast(bf16x8_t, vv); \
                O[dt][0] = __builtin_amdgcn_mfma_f32_16x16x32_bf16(vf, Pf[0], O[dt][0], 0, 0, 0); \
                O[dt][1] = __builtin_amdgcn_mfma_f32_16x16x32_bf16(vf, Pf[1], O[dt][1], 0, 0, 0); } \
            __builtin_amdgcn_sched_barrier(0); } while (0)
        NA_FETCH(0, skA0, skA1, svA0, svA1); NA_FETCH(1, skB0, skB1, svB0, svB1);
        NA_PUT(0, skA0, skA1, svA0, svA1);
        __syncthreads();
#define NA_STEP(s_, skx0, skx1, svx0, svx1, sky0, sky1, svy0, svy1) do { const int s = (s_); const int buf = s & 1; \
            NA_FETCH((s + 2 < nsteps ? s + 2 : nsteps - 1), skx0, skx1, svx0, svx1);        \
            __builtin_amdgcn_sched_barrier(0); \
            if (s < 4) { \
                NA_TILES(buf, 0, 1, 0, 0, (s == 0)); \
                NA_TILES(buf, 2, 3, 0, 0, false); \
            } else { \
                const int rho = rho0 + s - 4; \
                if (rho >= r0 && rho < r0 + 8 && s < nsteps) { \
                    const int drow = rho - r + 7; \
                    NA_TILES(buf, ct0, ct0 + 1, 1, drow, false); \
                    NA_TILES(buf, ct0 + 2, ct0 + 2, 2, drow, false); \
                } \
            } \
            NA_PUT(buf ^ 1, sky0, sky1, svy0, svy1); \
            __syncthreads(); } while (0)
#pragma unroll 1
        for (int s2 = 0; s2 < nsteps; s2 += 2) {
            NA_STEP(s2, skA0, skA1, svA0, svA1, skB0, skB1, svB0, svB1);
            NA_STEP(s2 + 1, skB0, skB1, svB0, svB1, skA0, skA1, svA0, svA1);
        }
#undef NA_STEP
#undef NA_FETCH
#undef NA_PUT
#undef NA_TILES
#pragma unroll
        for (int qt = 0; qt < 2; ++qt) {
            float l = lsum[qt];
            l += __shfl_xor(l, 16, 64); l += __shfl_xor(l, 32, 64);
            const float inv = 1.0f / l;
            const int l2 = fresh_tid(w) & 63;
            const unsigned oo = (unsigned)((b * SEQ + r * 64 + q0col + 16 * qt + (l2 & 15)) * D + h * 128 + 4 * (l2 >> 4)) * 2u;
#pragma unroll
            for (int dt = 0; dt < 8; ++dt) {
                v2u o; o.x = pk2(O[dt][qt][0] * inv, O[dt][qt][1] * inv); o.y = pk2(O[dt][qt][2] * inv, O[dt][qt][3] * inv);
                *(v2u*)((char*)p.CAT + oo + 32 * dt) = o;
            }
        }
    }
    __syncthreads();
}

__device__ __forceinline__ int hg_row(int dir, int b, int s) {
    if (dir == 0) return s < CTXL ? TL + b * CTXL + s : b * SEQ + (s - CTXL);
    return s < CTXL ? TL + b * CTXL + (CTXL - 1 - s) : b * SEQ + (SEQ - 1 - (s - CTXL));
}
__device__ __forceinline__ void st_hg_prep(const int tid_, const Args& p) {
    for (int ck = blockIdx.x; ck < T / 16; ck += gridDim.x) {
        const int row0 = ck * 16;
        int b, key0;
        if (row0 < TL) { b = row0 >> 12; key0 = row0 & 4095; } else { b = (row0 - TL) >> 8; key0 = 4096 + ((row0 - TL) & 255); }
        bf16 rq[2][16], rf[2][2][16];
#pragma unroll
        for (int cc = 0; cc < 2; ++cc)
#pragma unroll
            for (int t = 0; t < 16; ++t) {
                const bf16* z = p.Z16 + (size_t)(row0 + t) * 8192 + tid_ + cc * 512;
                rq[cc][t] = z[3 * 1024]; rf[cc][0][t] = z[4 * 1024]; rf[cc][1][t] = z[5 * 1024];
            }
#pragma unroll
        for (int cc = 0; cc < 2; ++cc) {
            const int c = tid_ + cc * 512, h = c >> 7, d = c & 127;
            float q[16];
#pragma unroll
            for (int t = 0; t < 16; ++t) { const float x = bf2f(rq[cc][t]); q[t] = x * __builtin_amdgcn_rcpf(1.0f + __expf(-x)); }
#pragma unroll
            for (int dir = 0; dir < 2; ++dir) {
                const float lb = sigmoidf_(p.hgrn_lb[(dir * 2 + 1) * 1024 + c] - p.hgrn_lb[(dir * 2 + 0) * 1024 + c]);
                float k[16], Pp[16];
                float run = 1.f;
#pragma unroll
                for (int t = 0; t < 16; ++t) {
                    const float x = bf2f(rf[cc][dir][t]);
                    const float sg = __builtin_amdgcn_rcpf(1.0f + __expf(-x));
                    const float f = lb + (1.0f - lb) * sg;
                    k[t] = (1.0f - lb) * (1.0f - sg);
                    run *= f;
                    Pp[t] = run;
                }
                const float etot = run;
                unsigned kh[8];
#pragma unroll
                for (int t = 0; t < 16; ++t) {
                    const float pm1 = t ? Pp[t - 1] : 1.0f;
                    const float eG = dir ? etot * __builtin_amdgcn_rcpf(pm1) : Pp[t];
                    const float enG = __builtin_amdgcn_rcpf(eG);
                    const float eR = etot * enG;
                    const size_t o = ((((size_t)dir * (T / 16) + ck) * 8 + h) * 16 + t) * 128 + d;
                    p.QT[o] = (bf16)f2bf(q[t] * eG);
                    p.KT[o] = (bf16)f2bf(k[t] * enG);
                    const unsigned hb = f2bf(k[t] * eR);
                    if (t & 1) kh[t >> 1] |= hb << 16; else kh[t >> 1] = hb;
                }
                bf16* kd = p.KHT + (((size_t)(dir * 32 + b * 8 + h) * 272 + (key0 >> 4)) * 128 + d) * 16;
                v4u w0, w1; w0.x = kh[0]; w0.y = kh[1]; w0.z = kh[2]; w0.w = kh[3]; w1.x = kh[4]; w1.y = kh[5]; w1.z = kh[6]; w1.w = kh[7];
                *(v4u*)kd = w0; *(v4u*)(kd + 8) = w1;
                p.DEC[((size_t)dir * (T / 16) + ck) * 1024 + c] = etot;
            }
        }
    }
}
struct HgS { v2u a0, a1, b0, b1; f32x4_t d0, d1; };
struct HgO { v2u v0; bf16x8_t qf[4], kf[4]; };
__device__ __forceinline__ void hg_rowkey(int ci, int dir, int b, int& row0, int& key0) {
    const int c = ci < 272 ? ci : 271;
    const int isctx = c < 16 ? 1 : 0;
    const int cc = isctx ? (dir ? 15 - c : c) : (dir ? 255 - (c - 16) : c - 16);
    row0 = (isctx ? TL + b * CTXL : b * SEQ) + 16 * cc;
    key0 = (isctx ? 4096 : 0) + 16 * cc;
}
#define HG_BAR() do { asm volatile("s_waitcnt lgkmcnt(0)" ::: "memory"); __builtin_amdgcn_s_barrier(); asm volatile("" ::: "memory"); } while (0)
#define HG_FRAG(x_) __builtin_bit_cast(bf16x8_t, (v4u){(x_).x, (x_).y, 0u, 0u})
__device__ __forceinline__ void st_hg_seq(const int tid_, const Args& p, float* lds) {
    const int lane = tid_ & 63, w = __builtin_amdgcn_readfirstlane(tid_ >> 6), li = lane & 15, g = lane >> 4;
    bf16* SL = (bf16*)lds;
    for (int u = blockIdx.x; u < 256; u += gridDim.x) {
        const int b = u >> 6, h = (u >> 3) & 7, dir = (u >> 2) & 1, vq = u & 3;
        __syncthreads();
        for (int i = tid_; i < 4 * 32 * 136 / 2; i += NT) ((unsigned*)SL)[i] = 0u;
        __syncthreads();
        if (w < 4) {
            f32x4_t S00 = (f32x4_t){0.f, 0.f, 0.f, 0.f}, S01 = S00, S10 = S00, S11 = S00;
            const bf16* vtb = p.VT6 + ((size_t)(b * 8 + h) * 272 * 128 + vq * 32 + li) * 16 + 4 * g;
            const bf16* khb = p.KHT + ((size_t)(dir * 32 + b * 8 + h) * 272 * 128 + 32 * w + li) * 16 + 4 * g;
            const float* decb = p.DEC + (size_t)dir * (T / 16) * 1024 + h * 128 + 32 * w + 4 * g;
#define S_LOAD(R, ci_) do { int r0_, k0_; hg_rowkey((ci_), dir, b, r0_, k0_); const size_t kc_ = (size_t)(k0_ >> 4) * 2048; \
            R.a0 = *(const v2u*)(vtb + kc_); R.a1 = *(const v2u*)(vtb + kc_ + 256); R.b0 = *(const v2u*)(khb + kc_); R.b1 = *(const v2u*)(khb + kc_ + 256); \
            R.d0 = *(const f32x4_t*)(decb + (size_t)(r0_ >> 4) * 1024); R.d1 = *(const f32x4_t*)(decb + (size_t)(r0_ >> 4) * 1024 + 16); } while (0)
#define S_STEP(R, ci_) do { \
            const bf16x8_t vf0 = HG_FRAG(R.a0), vf1 = HG_FRAG(R.a1), kf0 = HG_FRAG(R.b0), kf1 = HG_FRAG(R.b1); \
            S00 = S00 * R.d0; S01 = S01 * R.d0; S10 = S10 * R.d1; S11 = S11 * R.d1; \
            S00 = __builtin_amdgcn_mfma_f32_16x16x32_bf16(kf0, vf0, S00, 0, 0, 0); S01 = __builtin_amdgcn_mfma_f32_16x16x32_bf16(kf0, vf1, S01, 0, 0, 0); \
            S10 = __builtin_amdgcn_mfma_f32_16x16x32_bf16(kf1, vf0, S10, 0, 0, 0); S11 = __builtin_amdgcn_mfma_f32_16x16x32_bf16(kf1, vf1, S11, 0, 0, 0); \
            bf16* sn = SL + (((ci_) + 1) & 3) * 32 * 136 + li * 136 + 32 * w + 4 * g;        \
            { v2u o_; o_.x = cvtpk(S00[0], S00[1]); o_.y = cvtpk(S00[2], S00[3]); *(v2u*)(sn) = o_; } \
            { v2u o_; o_.x = cvtpk(S01[0], S01[1]); o_.y = cvtpk(S01[2], S01[3]); *(v2u*)(sn + 16 * 136) = o_; } \
            { v2u o_; o_.x = cvtpk(S10[0], S10[1]); o_.y = cvtpk(S10[2], S10[3]); *(v2u*)(sn + 16) = o_; } \
            { v2u o_; o_.x = cvtpk(S11[0], S11[1]); o_.y = cvtpk(S11[2], S11[3]); *(v2u*)(sn + 16 * 136 + 16) = o_; } \
            HG_BAR(); } while (0)
            HgS s0, s1, s2, s3, s4, s5, s6, s7;
            S_LOAD(s0, 0); S_LOAD(s1, 1); S_LOAD(s2, 2); S_LOAD(s3, 3); S_LOAD(s4, 4); S_LOAD(s5, 5); S_LOAD(s6, 6);
            for (int ci = 0; ci < 272; ci += 8) {
                S_LOAD(s7, ci + 7);  S_STEP(s0, ci);
                S_LOAD(s0, ci + 8);  S_STEP(s1, ci + 1);
                S_LOAD(s1, ci + 9);  S_STEP(s2, ci + 2);
                S_LOAD(s2, ci + 10); S_STEP(s3, ci + 3);
                S_LOAD(s3, ci + 11); S_STEP(s4, ci + 4);
                S_LOAD(s4, ci + 12); S_STEP(s5, ci + 5);
                S_LOAD(s5, ci + 13); S_STEP(s6, ci + 6);
                S_LOAD(s6, ci + 14); S_STEP(s7, ci + 7);
            }
            HG_BAR();
#undef S_LOAD
#undef S_STEP
        } else {
            const int ovt = w & 1, sh = (w >> 1) & 1;
            const bf16* vtb = p.VT6 + ((size_t)(b * 8 + h) * 272 * 128 + vq * 32 + ovt * 16 + li) * 16 + 4 * g;
            const bf16* qtb = p.QT + (((size_t)dir * (T / 16) * 8 + h) * 16 + li) * 128 + 8 * g;
            const bf16* ktb = p.KT + (((size_t)dir * (T / 16) * 8 + h) * 16 + li) * 128 + 8 * g;
            bf16* OUT = (bf16*)(dir ? p.OB : p.OF) + h * 128 + vq * 32 + ovt * 16 + 4 * g;
            v2u pfk = {0u, 0u};
#define O_LOAD(R, ci_) do { int r0_, k0_; hg_rowkey((ci_), dir, b, r0_, k0_); R.v0 = *(const v2u*)(vtb + (size_t)(k0_ >> 4) * 2048); const size_t qc_ = (size_t)(r0_ >> 4) * (8 * 16 * 128); \
            _Pragma("unroll") for (int ks = 0; ks < 4; ++ks) { R.qf[ks] = *(const bf16x8_t*)(qtb + qc_ + 32 * ks); R.kf[ks] = *(const bf16x8_t*)(ktb + qc_ + 32 * ks); } } while (0)
#define O_STEP(R, ci_) do { \
            { f32x4_t att0 = (f32x4_t){0.f, 0.f, 0.f, 0.f}, att1 = (f32x4_t){0.f, 0.f, 0.f, 0.f}; \
              att0 = __builtin_amdgcn_mfma_f32_16x16x32_bf16(R.kf[0], R.qf[0], att0, 0, 0, 0); att1 = __builtin_amdgcn_mfma_f32_16x16x32_bf16(R.kf[1], R.qf[1], att1, 0, 0, 0); \
              att0 = __builtin_amdgcn_mfma_f32_16x16x32_bf16(R.kf[2], R.qf[2], att0, 0, 0, 0); att1 = __builtin_amdgcn_mfma_f32_16x16x32_bf16(R.kf[3], R.qf[3], att1, 0, 0, 0); \
              float am[4]; \
              _Pragma("unroll") for (int i = 0; i < 4; ++i) { const int sidx = 4 * g + i; const bool keep = dir ? (sidx >= li) : (sidx <= li); am[i] = keep ? (att0[i] + att1[i]) : 0.f; } \
              pfk.x = cvtpk(am[0], am[1]); pfk.y = cvtpk(am[2], am[3]); } \
            HG_BAR(); \
            { int row0, key0; hg_rowkey((ci_), dir, b, row0, key0); (void)key0; \
              const bf16* so = SL + ((ci_) & 3) * 32 * 136 + (ovt * 16 + li) * 136 + 8 * g; \
              bf16x8_t sf[4]; _Pragma("unroll") for (int ks = 0; ks < 4; ++ks) sf[ks] = *(const bf16x8_t*)(so + 32 * ks); \
              f32x4_t O0 = (f32x4_t){0.f, 0.f, 0.f, 0.f}, O1 = (f32x4_t){0.f, 0.f, 0.f, 0.f}; \
              O0 = __builtin_amdgcn_mfma_f32_16x16x32_bf16(sf[0], R.qf[0], O0, 0, 0, 0); O1 = __builtin_amdgcn_mfma_f32_16x16x32_bf16(sf[1], R.qf[1], O1, 0, 0, 0); \
              O0 = __builtin_amdgcn_mfma_f32_16x16x32_bf16(sf[2], R.qf[2], O0, 0, 0, 0); O1 = __builtin_amdgcn_mfma_f32_16x16x32_bf16(sf[3], R.qf[3], O1, 0, 0, 0); \
              O0 = __builtin_amdgcn_mfma_f32_16x16x32_bf16(HG_FRAG(R.v0), HG_FRAG(pfk), O0, 0, 0, 0); \
              { const f32x4_t s_ = O0 + O1; v2u o_; o_.x = cvtpk(s_[0], s_[1]); o_.y = cvtpk(s_[2], s_[3]); *(v2u*)(OUT + (size_t)(row0 + li) * 1024) = o_; } }       \
            HG_BAR(); } while (0)
            if (sh) HG_BAR();
            HgO o0, o1, o2, o3;
            O_LOAD(o0, sh); O_LOAD(o1, 2 + sh); O_LOAD(o2, 4 + sh);
            for (int m = 0; m < 136; m += 4) {
                const int c = 2 * m + sh;
                O_LOAD(o3, c + 6);  O_STEP(o0, c);
                O_LOAD(o0, c + 8);  O_STEP(o1, c + 2);
                O_LOAD(o1, c + 10); O_STEP(o2, c + 4);
                O_LOAD(o2, c + 12); O_STEP(o3, c + 6);
            }
            if (!sh) HG_BAR();
#undef O_LOAD
#undef O_STEP
        }
    }
    __syncthreads();
}
#undef HG_BAR
#undef HG_FRAG
__device__ __forceinline__ void st_hgrn_out(const int tid_, const Args& p) {
    const int lane = tid_ & 63, gw = blockIdx.x * NWAVES + (tid_ >> 6), nw = gridDim.x * NWAVES;
    for (int row = gw; row < TL; row += nw) {
        float o[16];
        float ss = 0.f;
#pragma unroll
        for (int hh = 0; hh < 2; ++hh) {
            const v4u fw = *(const v4u*)((const bf16*)p.OF + (size_t)row * 1024 + lane * 16 + 8 * hh), bw = *(const v4u*)((const bf16*)p.OB + (size_t)row * 1024 + lane * 16 + 8 * hh);
            const unsigned fa[4] = {fw.x, fw.y, fw.z, fw.w}, ba[4] = {bw.x, bw.y, bw.z, bw.w};
#pragma unroll
            for (int q = 0; q < 4; ++q) {
                o[8 * hh + 2 * q] = __builtin_bit_cast(float, fa[q] << 16) + __builtin_bit_cast(float, ba[q] << 16);
                o[8 * hh + 2 * q + 1] = __builtin_bit_cast(float, fa[q] & 0xffff0000u) + __builtin_bit_cast(float, ba[q] & 0xffff0000u);
            }
        }
#pragma unroll
        for (int i = 0; i < 16; ++i) ss += o[i] * o[i];
        ss += __shfl_xor(ss, 1, 64); ss += __shfl_xor(ss, 2, 64); ss += __shfl_xor(ss, 4, 64);
        const float rs = 1.0f / sqrtf(ss / 128.0f + EPS);
#pragma unroll
        for (int hh = 0; hh < 2; ++hh) {
            const v4u gz = *(const v4u*)(p.Z16 + (size_t)row * 8192 + 7 * 1024 + lane * 16 + 8 * hh);
            const unsigned ga[4] = {gz.x, gz.y, gz.z, gz.w};
            unsigned ow[4];
#pragma unroll
            for (int q = 0; q < 4; ++q) {
                const int c = lane * 16 + 8 * hh + 2 * q;
                const float g0 = __builtin_bit_cast(float, ga[q] << 16), g1 = __builtin_bit_cast(float, ga[q] & 0xffff0000u);
                ow[q] = pk2(o[8 * hh + 2 * q] * rs * p.hgrn_norm_g[c & 127] * siluf_(g0), o[8 * hh + 2 * q + 1] * rs * p.hgrn_norm_g[(c + 1) & 127] * siluf_(g1));
            }
            *(v4u*)(p.CAT + (size_t)row * D + 1024 + lane * 16 + 8 * hh) = (v4u){ow[0], ow[1], ow[2], ow[3]};
        }
    }
}
__device__ __forceinline__ void st_final(const int tid_, const Args& p) {
    const int lane = tid_ & 63, gw = blockIdx.x * NWAVES + (tid_ >> 6), nw = gridDim.x * NWAVES;
    for (int row = gw; row < TL; row += nw) {
        const float4* xr = (const float4*)(p.X + (size_t)row * D);
        float4 v[8];
        float ss = 0.f;
#pragma unroll
        for (int i = 0; i < 8; ++i) { v[i] = xr[lane + 64 * i]; ss += v[i].x * v[i].x + v[i].y * v[i].y + v[i].z * v[i].z + v[i].w * v[i].w; }
        ss = wave_sum(ss);
        const float rs = 1.0f / sqrtf(ss / D + EPS);
#pragma unroll
        for (int i = 0; i < 8; ++i) {
            const float4 gg = ((const float4*)p.final_g)[lane + 64 * i];
            ((float4*)(p.out + (size_t)row * D))[lane + 64 * i] = make_float4(v[i].x * rs * gg.x, v[i].y * rs * gg.y, v[i].z * rs * gg.z, v[i].w * rs * gg.w);
        }
    }
}

__global__ void __launch_bounds__(NT, 2) mega_fwd(Args p) {
    extern __shared__ __attribute__((aligned(16))) unsigned char lds_raw[];
    LAS unsigned char* ldsl = (LAS unsigned char*)lds_raw;
    float* lds = (float*)lds_raw;
    const int wave_id = __builtin_amdgcn_readfirstlane((int)threadIdx.x >> 6);
#define FT() fresh_tid(wave_id)
    volatile LAS unsigned* MISC = (volatile LAS unsigned*)(ldsl + MISC_OFF);
    for (int u = FT(); u < (LDS_BYTES - LDSCTL_OFF) / 4; u += NT) ((LAS unsigned*)(ldsl + LDSCTL_OFF))[u] = 0u;
    __syncthreads();
    XcdBarrier bar; bar.bar = p.ctl + CW_BAR; bar.x = 0; bar.st = nullptr;
    if (!MK_PER_PHASE) bar = xcd_barrier_post(p.ctl + CW_BAR, MISC + 8);
    const int lo = p.ph_lo, hi = p.ph_hi;
    const int Gd = (int)gridDim.x, bx = (int)blockIdx.x;
#ifndef PROBE_DUP
#define PROBE_DUP 0u
#endif
#define PH_BEGIN(k) if (lo <= (k) && (k) < hi) { for (int rep_ = 0; rep_ < (((PROBE_DUP >> (k)) & 1u) ? 2 : 1); ++rep_) {
#define PH_END(k) } if ((k) + 1 < hi) { if (!MK_PER_PHASE) xcd_barrier(bar, FT()); } }

    PH_BEGIN(0) { const int t0_ = FT(); if (bx == 0 && t0_ < 256) ((v4u*)(p.H + (size_t)T * D))[t0_] = (v4u){0u, 0u, 0u, 0u}; } st_weights(FT(), p, lds); st_ada(FT(), p, lds); PH_END(0)
    PH_BEGIN(1) st_router_prep(FT(), p); st_norm_mod(FT(), p, 0, T); PH_END(1)
    PH_BEGIN(2) { pg8::Gemm g{p.H, p.WinT0, T, 4096, D}; pg8::StaticOrder S; S.init(T, 4096, Gd, bx); pg8::EpiBf16 E{p.Z16, 4096, 16};
                  pg8::gemm_phase<pg8::EpiBf16, pg8::StaticOrder, PG8_ALIGN, PG8_SP2>(FT(), ldsl, g, S, E); } PH_END(2)
    PH_BEGIN(3) { const bool sw_ = ((bx >> 3) & 1) != 0;
                  if (sw_) st_l0_pre(FT(), p); st_l0_lru(FT(), p, lds); if (!sw_) st_l0_pre(FT(), p); } PH_END(3)
    PH_BEGIN(4) st_l0_carry(FT(), p); st_l0_conf(FT(), p, lds); PH_END(4)
    PH_BEGIN(5) st_l0_cat(FT(), p); PH_END(5)
    PH_BEGIN(6) { pg8::Gemm g{p.CAT, p.WoutT0, T, D, D}; pg8::StaticOrder S; S.init(T, D, Gd, bx); pg8::EpiResid E{(pg8::bf16_t*)p.X, p.x, p.ctx, p.MOD + 2 * D, 8, TL, D};
                  pg8::gemm_phase<pg8::EpiResid, pg8::StaticOrder, PG8_ALIGN, PG8_SP2>(FT(), ldsl, g, S, E); } PH_END(6)
    PH_BEGIN(7) st_post_mixer(FT(), p, 0, T, lds); PH_END(7)
    PH_BEGIN(8) st_topk(FT(), p, true, lds); st_norm_mod(FT(), p, 0, T, 1, Gd > 64 ? 64 : 0); PH_END(8)
    PH_BEGIN(9) { pg8::Gemm g{p.H, p.WupT, NE * MEP, NE * 4096, D}; pg8::GroupOrder S; S.init(9, 9, 16, NE, Gd, bx); S.list = p.LIST; S.lstride = ME; S.nslots = ME; S.zero_row = T; pg8::EpiSwiGLU E{p.HID, D, 16};
                   pg8::gemm_phase<pg8::EpiSwiGLU, pg8::GroupOrder, PG8_ALIGN, PG8_SP2, true>(FT(), ldsl, g, S, E); } PH_END(9)
    PH_BEGIN(10) { pg8::Gemm g{p.HID, p.WdnT, NE * MEP, NE * D, D}; pg8::GroupOrder S; S.init(9, 9, 8, NE, Gd, bx); S.list = nullptr; S.lstride = 0; S.nslots = 0; S.zero_row = 0; pg8::EpiBf16 E{p.Y16, D, 8};
                   pg8::gemm_phase<pg8::EpiBf16, pg8::GroupOrder, PG8_ALIGN, PG8_SP2>(FT(), ldsl, g, S, E); } PH_END(10)
    PH_BEGIN(11) st_combine<false>(FT(), p, 0, T); st_norm_mod(FT(), p, 1, T); PH_END(11)
    PH_BEGIN(12) { pg8::Gemm g{p.H, p.WinT1, T, 8192, D}; pg8::StaticOrder S; S.init(T, 8192, Gd, bx); pg8::EpiBf16 E{p.Z16, 8192, 32};
                   pg8::gemm_phase<pg8::EpiBf16, pg8::StaticOrder, PG8_ALIGN, PG8_SP2>(FT(), ldsl, g, S, E); } PH_END(12)
    PH_BEGIN(13) { const bool sw_ = ((bx >> 3) & 1) != 0;
                   if (sw_) st_hg_prep(FT(), p); st_vt(FT(), p, lds, 2, p.VT); st_vt(FT(), p, lds, 6, p.VT6); if (!sw_) st_hg_prep(FT(), p); } PH_END(13)
    PH_BEGIN(14) st_hg_seq(FT(), p, lds); st_na(FT(), p, lds); PH_END(14)
    PH_BEGIN(15) st_hgrn_out(FT(), p); PH_END(15)
    PH_BEGIN(16) { pg8::Gemm g{p.CAT, p.WoutT1, TL, D, D}; pg8::StaticOrder S; S.init(TL, D, Gd, bx); pg8::EpiResid E{(pg8::bf16_t*)p.X, nullptr, nullptr, p.MOD + (size_t)5 * 12288 + 2 * D, 8, TL, D};
                   pg8::gemm_phase<pg8::EpiResid, pg8::StaticOrder, PG8_ALIGN, PG8_SP2>(FT(), ldsl, g, S, E); } PH_END(16)
    PH_BEGIN(17) st_post_mixer(FT(), p, 1, TL, lds); PH_END(17)
    PH_BEGIN(18) st_topk(FT(), p, false, lds); st_norm_mod(FT(), p, 1, TL, 1, Gd > 64 ? 64 : 0); PH_END(18)
    PH_BEGIN(19) { pg8::Gemm g{p.H, p.WupT + (size_t)NE * 4096 * D, NE * MEP, NE * 4096, D}; pg8::GroupOrder S; S.init(8, 9, 16, NE, Gd, bx); S.list = p.LIST; S.lstride = ME; S.nslots = 2048; S.zero_row = T; pg8::EpiSwiGLU E{p.HID, D, 16};
                   pg8::gemm_phase<pg8::EpiSwiGLU, pg8::GroupOrder, PG8_ALIGN, PG8_SP2, true>(FT(), ldsl, g, S, E); } PH_END(19)
    PH_BEGIN(20) { pg8::Gemm g{p.HID, p.WdnT + (size_t)NE * D * D, NE * MEP, NE * D, D}; pg8::GroupOrder S; S.init(8, 9, 8, NE, Gd, bx); S.list = nullptr; S.lstride = 0; S.nslots = 0; S.zero_row = 0; pg8::EpiBf16 E{p.Y16, D, 8};
                   pg8::gemm_phase<pg8::EpiBf16, pg8::GroupOrder, PG8_ALIGN, PG8_SP2>(FT(), ldsl, g, S, E); } PH_END(20)
    PH_BEGIN(21) st_combine<true>(FT(), p, 1, TL); PH_END(21)
#undef PH_BEGIN
#undef PH_END
}
}

extern "C" void kernel_launch(void* const* d_in, const int* in_sizes, int n_in, void* d_out, int out_size, void* d_ws, size_t ws_size,
                              hipStream_t stream) {
    static int grid = 0;
    if (grid == 0) {
        int dev = 0, cus = 0;
        if (hipGetDevice(&dev) != hipSuccess || hipDeviceGetAttribute(&cus, hipDeviceAttributeMultiprocessorCount, dev) != hipSuccess) { fprintf(stderr, "kernel_launch: device query failed\n"); grid = -1; return; }
        if (hipFuncSetAttribute((const void*)mega_fwd, hipFuncAttributeMaxDynamicSharedMemorySize, LDS_BYTES) != hipSuccess) { fprintf(stderr, "kernel_launch: hipFuncSetAttribute failed\n"); grid = -1; return; }
        (void)hipGetLastError();
        grid = cus;
    }
    if (grid < 0) return;
    Args p{};
    const float** f = (const float**)&p;
    for (int i = 0; i < 30; ++i) f[i] = (const float*)d_in[i];
    p.out = (float*)d_out;
    char* w = (char*)d_ws;
    size_t off = 0;
    auto take = [&](size_t bytes) { void* r = w + off; off += (bytes + 255) & ~(size_t)255; return r; };
    p.ctl = (unsigned*)take(CTL_BYTES);
    p.WinT0 = (bf16*)take((size_t)4096 * D * 2);
    p.WoutT0 = (bf16*)take((size_t)D * D * 2);
    p.WinT1 = (bf16*)take((size_t)8192 * D * 2);
    p.WoutT1 = (bf16*)take((size_t)D * D * 2);
    p.WupT = (bf16*)take((size_t)2 * NE * 4096 * D * 2);
    p.WdnT = (bf16*)take((size_t)2 * NE * D * D * 2);
    p.X = (float*)take((size_t)T * D * 4);
    p.H = (bf16*)take((size_t)(T + 1) * D * 2);
    p.MOD = (float*)take((size_t)2 * 5 * 12288 * 4);
    p.AFF = (float*)take((size_t)T * NE * 4);
    p.SLOTOF = (int*)take((size_t)T * NE * 4);
    p.LIST = (int*)take((size_t)NE * ME * 4);
    p.GATEV = (float*)take((size_t)NE * ME * 4);
    p.TSP = (float*)take((size_t)(T / 64) * 2 * 1024 * 4);
    p.TSH = (float*)take((size_t)(T / 64) * 2 * 1024 * 4);
    p.CIN = (float*)take((size_t)(T / 64) * 2 * 1024 * 4);
    p.DEC = (float*)take((size_t)2 * (T / 16) * 1024 * 4);
    p.RTH = (bf16*)take((size_t)2 * 5 * NE * D * 2);
    p.RTL = (bf16*)take((size_t)2 * 5 * NE * D * 2);
    p.RBIAS = (float*)take((size_t)2 * 5 * NE * 4);
    const size_t scratch0 = off;
    p.Z = (float*)take((size_t)T * 8192 * 4);
    p.CAT = (bf16*)take((size_t)T * D * 2);
    p.O = (float*)take((size_t)T * D * 4);
    p.AB = (float*)take((size_t)T * G * 4);
    p.BB = (float*)take((size_t)T * G * 4);
    const size_t end_mixer = off;
    p.U = p.Z + (size_t)T * 4096;
    p.XL = p.U + (size_t)T * G;
    p.AF = p.XL + (size_t)T * G;
    p.BF = p.AF + (size_t)T * G;
    p.OF = p.AB; p.OB = p.BB;
    p.Z16 = (bf16*)p.Z;
    p.VT = (bf16*)(p.Z + (size_t)T * 4096);
    p.VT6 = p.VT + (size_t)32 * 128 * 4352;
    p.KHT = p.VT6 + (size_t)32 * 128 * 4352;
    p.QT = p.KHT + (size_t)2 * 32 * 128 * 4352;
    p.KT = p.QT + (size_t)2 * T * 1024;
    off = scratch0;
    p.XS = (bf16*)take((size_t)NE * MEP * D * 2);
    p.HID = (bf16*)take((size_t)NE * MEP * D * 2);
    p.Y16 = (bf16*)take((size_t)NE * MEP * D * 2); p.Y = nullptr;
    const size_t need = off > end_mixer ? off : end_mixer;
    if (need > ws_size) { fprintf(stderr, "kernel_launch: workspace too small: need %zu have %zu\n", need, ws_size); return; }
    (void)in_sizes; (void)n_in; (void)out_size;
    if (hipMemsetAsync(p.ctl, 0, CTL_BYTES, stream) != hipSuccess) { fprintf(stderr, "kernel_launch: memset failed\n"); return; }
#if MK_PER_PHASE
    for (int k = 0; k < NPHASES; ++k) { p.ph_lo = k; p.ph_hi = k + 1; hipLaunchKernelGGL(mega_fwd, dim3(grid), dim3(NT), LDS_BYTES, stream, p); }
#else
    p.ph_lo = 0; p.ph_hi = NPHASES;
    hipLaunchKernelGGL(mega_fwd, dim3(grid), dim3(NT), LDS_BYTES, stream, p);
#endif
    const hipError_t le = hipPeekAtLastError();
    if (le != hipSuccess) fprintf(stderr, "kernel_launch: launch failed: %s\n", hipGetErrorName(le));
}
```
